# Optimizing an MI355X kernel written in HIP

```python
import math
import jax, jax.numpy as jnp
from jax import lax
import numpy as np

D_MODEL = 1024
BATCH = 8
SEQ = 4096
DEPTH = 2

HEAD_DIM = 64
RWKV_HEADS = 6
RWKV_WIDTH = RWKV_HEADS * HEAD_DIM
SB_HEADS = 6
SB_WIDTH = SB_HEADS * HEAD_DIM
POOL_WINDOWS = (2, 4, 8, 16)
POOL_GROUPS = len(POOL_WINDOWS)
POOL_WIDTH = D_MODEL - RWKV_WIDTH - SB_WIDTH
POOL_GROUP_DIM = POOL_WIDTH // POOL_GROUPS
DECAY_LORA = 64
AAA_LORA = 64
GATE_LORA = 128
MV_LORA = 32
RWKV_COLS = 3 * RWKV_WIDTH + DECAY_LORA + AAA_LORA + GATE_LORA
SB_COLS = 3 * SB_WIDTH
IN_COLS = RWKV_COLS + SB_COLS + POOL_WIDTH
D_FF = 2816
CONV_WIDTH = 3
Q_BLOCK = 128
NORM_EPS = 1e-6
LN_X_EPS = 64e-5
L2_EPS = 1e-12

kernel_name = "hymba_rwkv7_stickbreak_pool_convffn"

F32 = jnp.float32


def rms_norm(x, g, eps=NORM_EPS):
    xf = x.astype(F32)
    y = xf * lax.rsqrt(jnp.mean(xf * xf, axis=-1, keepdims=True) + eps) * g.astype(F32)
    return y.astype(x.dtype)


def token_shift(p):
    return jnp.pad(p, ((0, 0), (1, 0), (0, 0)))[:, :-1]


def wkv7_scan(r, decay, k, v, a_vec, b_vec):
    def step(S, inp):
        r_t, w_t, k_t, v_t, a_t, b_t = inp
        Sa = jnp.einsum('bhij,bhj->bhi', S, a_t)
        S = (S * w_t[:, :, None, :] + Sa[..., :, None] * b_t[..., None, :]
             + v_t[..., :, None] * k_t[..., None, :])
        y = jnp.einsum('bhij,bhj->bhi', S, r_t)
        return S, y
    B, T, H, N = r.shape
    xs = tuple(jnp.moveaxis(t, 1, 0) for t in (r, decay, k, v, a_vec, b_vec))
    S0 = jnp.zeros((B, H, N, N), F32)
    _, ys = lax.scan(step, S0, xs)
    return jnp.moveaxis(ys, 0, 1)


def rwkv7_time_mix(p, mu, w0, w2, a0, a2, g2, k_k, k_a, r_k, lnx_w, lnx_b, v_first, vmix):
    B, T, _ = p.shape
    H, N = RWKV_HEADS, HEAD_DIM
    p = p + (token_shift(p) - p) * mu
    cuts = np.cumsum([RWKV_WIDTH, RWKV_WIDTH, RWKV_WIDTH, DECAY_LORA, AAA_LORA])
    r, k, v, xw, xa, xg = jnp.split(p, cuts, axis=-1)
    w = -jax.nn.softplus(-(w0 + jnp.tanh(xw) @ w2)) - 0.5
    decay = jnp.exp(-jnp.exp(w))
    a = jax.nn.sigmoid(a0 + xa @ a2)
    g = jax.nn.sigmoid(xg) @ g2
    if vmix is None:
        v_first = v
    else:
        v0, v1, v2 = vmix
        v = v + (v_first - v) * jax.nn.sigmoid(v0 + (v @ v1) @ v2)
    kk = (k * k_k).reshape(B, T, H, N)
    kk = kk / jnp.maximum(jnp.sqrt(jnp.sum(kk * kk, axis=-1, keepdims=True)), L2_EPS)
    k = k * (1.0 + (a - 1.0) * k_a)
    rh, kh, vh = (t.reshape(B, T, H, N) for t in (r, k, v))
    ah = a.reshape(B, T, H, N)
    y = wkv7_scan(rh, decay.reshape(B, T, H, N), kh, vh, -kk, kk * ah)
    mean = jnp.mean(y, axis=-1, keepdims=True)
    var = jnp.mean(jnp.square(y - mean), axis=-1, keepdims=True)
    y = ((y - mean) * lax.rsqrt(var + LN_X_EPS)).reshape(B, T, RWKV_WIDTH) * lnx_w + lnx_b
    bonus = jnp.sum(rh * kh * r_k, axis=-1, keepdims=True) * vh
    y = (y + bonus.reshape(B, T, RWKV_WIDTH)) * g
    return y, v_first


def stick_breaking_attention(q, k, v, q_gain, k_gain):
    q = rms_norm(q, q_gain)
    k = rms_norm(k, k_gain)
    q, k, v = (jnp.transpose(t, (0, 2, 1, 3)) for t in (q, k, v))
    T = q.shape[2]
    scale = HEAD_DIM ** -0.5
    outs = []
    for t0 in range(0, T, Q_BLOCK):
        lk = t0 + Q_BLOCK
        qb, kp, vp = q[:, :, t0:lk], k[:, :, :lk], v[:, :, :lk]
        z = jnp.einsum('bhqd,bhkd->bhqk', qb, kp) * scale
        causal = jnp.arange(lk)[None, :] < (t0 + jnp.arange(Q_BLOCK))[:, None]
        log_not = jnp.where(causal, jax.nn.log_sigmoid(-z), 0.0)
        log_remaining = lax.cumsum(log_not, axis=3, reverse=True) - log_not
        A = jnp.where(causal, jnp.exp(jax.nn.log_sigmoid(z) + log_remaining), 0.0)
        outs.append(jnp.einsum('bhqk,bhkd->bhqd', A, vp))
    o = jnp.concatenate(outs, axis=2)
    B, H, _, N = o.shape
    return jnp.transpose(o, (0, 2, 1, 3)).reshape(B, T, H * N)


def multiscale_pool(u, lin_w, lin_b, scale):
    B, T, _ = u.shape
    ug = u.reshape(B, T, POOL_GROUPS, POOL_GROUP_DIM)
    cs = jnp.pad(jnp.cumsum(ug, axis=1), ((0, 0), (1, 0), (0, 0), (0, 0)))
    pos = jnp.arange(T)
    pooled = []
    for g, w in enumerate(POOL_WINDOWS):
        start = jnp.maximum(pos + 1 - w, 0)
        win_sum = cs[:, 1:, g] - cs[:, start, g]
        count = jnp.minimum(pos + 1, w).astype(F32)[:, None]
        pooled.append(win_sum / count)
    pooled = jnp.stack(pooled, axis=2) - ug
    y = jnp.einsum('btgc,gcd->btgd', pooled, lin_w) + lin_b
    return y.reshape(B, T, POOL_WIDTH) * scale


def conv_glu_ffn(h, w_up, conv_w, conv_b, w_down):
    T = h.shape[1]
    up = h @ w_up
    padded = jnp.pad(up, ((0, 0), (CONV_WIDTH - 1, 0), (0, 0)))
    c = conv_b
    for i in range(CONV_WIDTH):
        c = c + padded[:, i:i + T] * conv_w[i]
    gate, val = jnp.split(c, 2, axis=-1)
    return (jax.nn.silu(gate) * val) @ w_down


def setup_inputs(seed: int = 0) -> dict:
    key = jax.random.key(seed)
    ks = jax.random.split(key, 32)
    nrm = lambda k, shape, s: jax.random.normal(k, shape, F32) * s
    L, Lv = DEPTH, DEPTH - 1
    return {
        "x": jax.random.normal(ks[0], (BATCH, SEQ, D_MODEL), F32),
        "ln1_g": 1.0 + nrm(ks[1], (L, D_MODEL), 0.05),
        "w_in": nrm(ks[2], (L, D_MODEL, IN_COLS), D_MODEL ** -0.5),
        "mu_shift": jax.random.uniform(ks[3], (L, RWKV_COLS), F32),
        "w0": jax.random.uniform(ks[4], (L, RWKV_WIDTH), F32, -6.0, 0.0),
        "w2": nrm(ks[5], (L, DECAY_LORA, RWKV_WIDTH), 0.1 * DECAY_LORA ** -0.5),
        "a0": nrm(ks[6], (L, RWKV_WIDTH), 0.1),
        "a2": nrm(ks[7], (L, AAA_LORA, RWKV_WIDTH), AAA_LORA ** -0.5),
        "g2": nrm(ks[8], (L, GATE_LORA, RWKV_WIDTH), GATE_LORA ** -0.5),
        "k_k": 0.85 + nrm(ks[9], (L, RWKV_WIDTH), 0.05),
        "k_a": 1.0 + nrm(ks[10], (L, RWKV_WIDTH), 0.05),
        "r_k": nrm(ks[11], (L, RWKV_HEADS, HEAD_DIM), 0.1),
        "lnx_w": 1.0 + nrm(ks[12], (L, RWKV_WIDTH), 0.05),
        "lnx_b": nrm(ks[13], (L, RWKV_WIDTH), 0.02),
        "v0": 1.0 + nrm(ks[14], (Lv, RWKV_WIDTH), 0.1),
        "v1": nrm(ks[15], (Lv, RWKV_WIDTH, MV_LORA), RWKV_WIDTH ** -0.5),
        "v2": nrm(ks[16], (Lv, MV_LORA, RWKV_WIDTH), MV_LORA ** -0.5),
        "q_gain": 1.0 + nrm(ks[17], (L, HEAD_DIM), 0.05),
        "k_gain": 1.0 + nrm(ks[18], (L, HEAD_DIM), 0.05),
        "pool_w": nrm(ks[19], (L, POOL_GROUPS, POOL_GROUP_DIM, POOL_GROUP_DIM), POOL_GROUP_DIM ** -0.5),
        "pool_b": nrm(ks[20], (L, POOL_GROUPS, POOL_GROUP_DIM), 0.02),
        "pool_scale": 1.0 + nrm(ks[21], (L, POOL_WIDTH), 0.1),
        "w_out": nrm(ks[22], (L, D_MODEL, D_MODEL), D_MODEL ** -0.5),
        "ln2_g": 1.0 + nrm(ks[23], (L, D_MODEL), 0.05),
        "w_up": nrm(ks[24], (L, D_MODEL, 2 * D_FF), D_MODEL ** -0.5),
        "conv_w": nrm(ks[25], (L, CONV_WIDTH, 2 * D_FF), CONV_WIDTH ** -0.5),
        "conv_b": nrm(ks[26], (L, 2 * D_FF), 0.02),
        "w_down": nrm(ks[27], (L, D_FF, D_MODEL), D_FF ** -0.5),
    }


def reference(x, ln1_g, w_in, mu_shift, w0, w2, a0, a2, g2, k_k, k_a, r_k, lnx_w, lnx_b,
              v0, v1, v2, q_gain, k_gain, pool_w, pool_b, pool_scale, w_out, ln2_g,
              w_up, conv_w, conv_b, w_down):
    B, T, _ = x.shape
    v_first = None
    for l in range(DEPTH):
        h = rms_norm(x, ln1_g[l])
        proj = (h @ w_in[l]).astype(F32)
        p_rwkv, p_sb, p_pool = jnp.split(proj, [RWKV_COLS, RWKV_COLS + SB_COLS], axis=-1)
        vmix = None if l == 0 else (v0[l - 1], v1[l - 1], v2[l - 1])
        y_rwkv, v_first = rwkv7_time_mix(p_rwkv, mu_shift[l], w0[l], w2[l], a0[l], a2[l], g2[l],
                                         k_k[l], k_a[l], r_k[l], lnx_w[l], lnx_b[l], v_first, vmix)
        q, k, v = (t.reshape(B, T, SB_HEADS, HEAD_DIM) for t in jnp.split(p_sb, 3, axis=-1))
        y_sb = stick_breaking_attention(q, k, v, q_gain[l], k_gain[l])
        y_pool = multiscale_pool(p_pool, pool_w[l], pool_b[l], pool_scale[l])
        mix = jnp.concatenate([y_rwkv, y_sb, y_pool], axis=-1).astype(x.dtype)
        x = x + mix @ w_out[l]
        x = x + conv_glu_ffn(rms_norm(x, ln2_g[l]), w_up[l], conv_w[l], conv_b[l], w_down[l])
    return x
```

```cpp
#include <hip/hip_runtime.h>
#include <stdint.h>
#include <cstdio>

typedef unsigned short bf16_t;
typedef short bf16x8 __attribute__((ext_vector_type(8)));
typedef float f32x4 __attribute__((ext_vector_type(4)));
typedef float f32x16 __attribute__((ext_vector_type(16)));
typedef unsigned u32x4 __attribute__((ext_vector_type(4)));
typedef unsigned u32x2 __attribute__((ext_vector_type(2)));

#define TID ((int)threadIdx.x)
__device__ __forceinline__ int otid() { int t = threadIdx.x; asm volatile("" : "+v"(t)); return t; }
constexpr int T_ = 4096, M_ = 32768;
constexpr size_t MiB = 1u << 20;
constexpr size_t OFF_BAR = 0;
constexpr size_t OFF_BONUS = 1 * MiB;
constexpr size_t OFF_SMALLW = 2 * MiB;
constexpr size_t OFF_WB = 3 * MiB;
constexpr size_t OFF_VFIRST = 51 * MiB;
constexpr size_t OFF_HBUF = 75 * MiB;
constexpr size_t OFF_G = 139 * MiB;
constexpr size_t OFF_SW = 163 * MiB;
constexpr size_t OFF_SR = 211 * MiB;
constexpr size_t OFF_SK = 235 * MiB;
constexpr size_t OFF_SV = 259 * MiB;
constexpr size_t OFF_SA = 283 * MiB;
constexpr size_t OFF_SB = 307 * MiB;
constexpr size_t OFF_PROJR = 331 * MiB;
constexpr size_t OFF_SBQ = 419 * MiB;
constexpr size_t OFF_SBK = 443 * MiB;
constexpr size_t OFF_SBVT = 467 * MiB;
constexpr size_t OFF_POOL = 491 * MiB;
constexpr size_t OFF_ACT = 163 * MiB;
constexpr size_t WB_LAYER = 12582912;
constexpr size_t WB_IN = 0, WB_OUT = 2883584, WB_UP = 3932160, WB_DOWN = 9699328;
constexpr size_t SW_LAYER = 139264;
constexpr size_t SW_W2 = 0, SW_A2 = 24576, SW_G2 = 49152, SW_POOL = 98304, SW_V1 = 114688, SW_V2 = 126976;

struct Params {
  const float* x; const float* ln1_g; const float* w_in; const float* mu; const float* w0; const float* w2; const float* a0; const float* a2; const float* g2;
  const float* k_k; const float* k_a; const float* r_k; const float* lnx_w; const float* lnx_b; const float* v0; const float* v1; const float* v2;
  const float* q_gain; const float* k_gain; const float* pool_w; const float* pool_b; const float* pool_scale; const float* w_out; const float* ln2_g;
  const float* w_up; const float* conv_w; const float* conv_b; const float* w_down;
  float* out; unsigned char* ws;
};

typedef __bf16 bf16x2_t __attribute__((ext_vector_type(2)));
typedef float f32x2_t __attribute__((ext_vector_type(2)));
__device__ __forceinline__ unsigned pk_bf16(float lo, float hi) { f32x2_t f = {lo, hi}; bf16x2_t b = __builtin_convertvector(f, bf16x2_t); return *reinterpret_cast<unsigned*>(&b); }
__device__ __forceinline__ float bf_lo(unsigned u) { return __uint_as_float(u << 16); }
__device__ __forceinline__ float bf_hi(unsigned u) { return __uint_as_float(u & 0xffff0000u); }
__device__ __forceinline__ bf16_t f2bf(float f) { return (bf16_t)(pk_bf16(f, 0.f) & 0xffffu); }
__device__ __forceinline__ bf16x8 pack8(const float* f) { u32x4 w = {pk_bf16(f[0], f[1]), pk_bf16(f[2], f[3]), pk_bf16(f[4], f[5]), pk_bf16(f[6], f[7])}; return *reinterpret_cast<bf16x8*>(&w); }
__device__ __forceinline__ void unpack8(u32x4 u, float* f) { f[0] = bf_lo(u.x); f[1] = bf_hi(u.x); f[2] = bf_lo(u.y); f[3] = bf_hi(u.y); f[4] = bf_lo(u.z); f[5] = bf_hi(u.z); f[6] = bf_lo(u.w); f[7] = bf_hi(u.w); }
__device__ __forceinline__ void unpack4(u32x2 u, float* f) { f[0] = bf_lo(u.x); f[1] = bf_hi(u.x); f[2] = bf_lo(u.y); f[3] = bf_hi(u.y); }
__device__ __forceinline__ u32x2 pack4(float a, float b, float c, float d) { u32x2 r = {pk_bf16(a, b), pk_bf16(c, d)}; return r; }
__device__ __forceinline__ float sigmoidf_(float x) { return __builtin_amdgcn_rcpf(1.f + __expf(-x)); }
__device__ __forceinline__ float softplusf_(float x) { return fmaxf(x, 0.f) + 0.69314718f * __builtin_amdgcn_logf(1.f + __expf(-fabsf(x))); }
__device__ __forceinline__ float tanhf_(float x) { float e = __expf(2.f * x); return 1.f - 2.f * __builtin_amdgcn_rcpf(e + 1.f); }
#define MFMA16(a, b, c) __builtin_amdgcn_mfma_f32_16x16x32_bf16((a), (b), (c), 0, 0, 0)
#define MFMA32(a, b, c) __builtin_amdgcn_mfma_f32_32x32x16_bf16((a), (b), (c), 0, 0, 0)

template <int CTRL> __device__ __forceinline__ float dppf(float x) { return __int_as_float(__builtin_amdgcn_update_dpp(0, __float_as_int(x), CTRL, 0xf, 0xf, true)); }
__device__ __forceinline__ float rowsum16(float x) {
  x += dppf<0xB1>(x);
  x += dppf<0x4E>(x);
  x += dppf<0x141>(x);
  x += dppf<0x140>(x);
  return x;
}
__device__ __forceinline__ float wavesum(float x) {
#pragma unroll
  for (int o = 32; o >= 1; o >>= 1) x += __shfl_xor(x, o);
  return x;
}

#define XB_XCNT(j) (64 * (1 + (j)))
#define XB_XSUB(j) (64 * (17 + (j)))
#define XB_XGEN(j) (64 * (33 + (j)))
#define XB_TOP (64 * 49)
#define XB_TOPGEN (64 * 50)
#define XB_BYTES (64 * 51 * 4)
__device__ __forceinline__ unsigned xb_ld(unsigned* p) { return __hip_atomic_load(p, __ATOMIC_RELAXED, __HIP_MEMORY_SCOPE_AGENT); }
__device__ __forceinline__ unsigned xb_add(unsigned* p, unsigned v) { return __hip_atomic_fetch_add(p, v, __ATOMIC_RELAXED, __HIP_MEMORY_SCOPE_AGENT); }
struct GridBar { unsigned* bar; unsigned x, nloc, nx; };
__device__ __forceinline__ void grid_barrier(GridBar& gb) {
  asm volatile("s_waitcnt vmcnt(0) lgkmcnt(0)" ::: "memory");
  __syncthreads();
  if (threadIdx.x == 0) {
    unsigned* bar = gb.bar;
    if (gb.nloc == 0u) {
      const unsigned G = gridDim.x;
      unsigned sum, cnt, mine;
      for (;;) {
        sum = 0u; cnt = 0u; mine = 0u;
#pragma unroll
        for (unsigned j = 0; j < 16; ++j) { const unsigned cc = xb_ld(&bar[XB_XCNT(j)]); sum += cc; cnt += (cc > 0u) ? 1u : 0u; mine = (j == gb.x) ? cc : mine; }
        if (sum == G) break;
        __builtin_amdgcn_s_sleep(1);
      }
      gb.nloc = mine; gb.nx = cnt;
    }
    const unsigned old = xb_add(&bar[XB_XSUB(gb.x)], 1u);
    const unsigned gen = old / gb.nloc;
    if (old + 1u == (gen + 1u) * gb.nloc) {
      __builtin_amdgcn_fence(__ATOMIC_RELEASE, "agent");
      asm volatile("s_waitcnt vmcnt(0)" ::: "memory");
      const unsigned og = xb_add(&bar[XB_TOP], 1u);
      const unsigned tg = og / gb.nx;
      if (og + 1u == (tg + 1u) * gb.nx) xb_add(&bar[XB_TOPGEN], 1u);
      else { while (xb_ld(&bar[XB_TOPGEN]) == tg) __builtin_amdgcn_s_sleep(1); }
      __builtin_amdgcn_fence(__ATOMIC_ACQUIRE, "agent");
      xb_add(&bar[XB_XGEN(gb.x)], 1u);
      asm volatile("s_waitcnt vmcnt(0)" ::: "memory");
    } else {
      while (xb_ld(&bar[XB_XGEN(gb.x)]) == gen) __builtin_amdgcn_s_sleep(20);
      __builtin_amdgcn_fence(__ATOMIC_ACQUIRE, "agent");
      asm volatile("s_waitcnt vmcnt(0)" ::: "memory");
    }
  }
  __syncthreads();
}

template <int PERM>
__device__ void transpose_big(const float* __restrict__ src, int K, int N, int Ndst, bf16_t* dst, int vb, int G, unsigned char* smem) {
  float* tile = (float*)smem;
  const int nkt = K >> 6, nnt = Ndst >> 6, ntile = nkt * nnt;
  const int tid_ = otid(); const int tl = tid_ & 63, th = tid_ >> 6;
  for (int tt = vb; tt < ntile; tt += G) {
    const int kt = tt % nkt, nt = tt / nkt;
    const int k0 = kt << 6, n0 = nt << 6;
    int sc;
    if (PERM == 0) sc = n0 + tl; else sc = (tl < 32) ? (nt * 32 + tl) : (2816 + nt * 32 + tl - 32);
#pragma unroll
    for (int i = 0; i < 16; ++i) { const int kk = i * 4 + th; tile[kk * 65 + tl] = src[(size_t)(k0 + kk) * N + sc]; }
    __syncthreads();
#pragma unroll
    for (int i = 0; i < 16; ++i) { const int nn = i * 4 + th; dst[(size_t)(n0 + nn) * K + k0 + tl] = f2bf(tile[tl * 65 + nn]); }
    __syncthreads();
  }
}
__device__ void transpose_small(const float* __restrict__ src, int K, int N, bf16_t* dst, int gt, int nt) {
  const int tot = K * N;
  for (int i = gt; i < tot; i += nt) { const int n = i / K, k = i - n * K; dst[i] = f2bf(src[(size_t)k * N + n]); }
}

__device__ void prep_phase(const Params& p, int part, int vb, int G, int gt, int nt, unsigned char* smem) {
  bf16_t* wb = (bf16_t*)(p.ws + OFF_WB);
  bf16_t* sw = (bf16_t*)(p.ws + OFF_SMALLW);
  for (int l = 0; l < 2; ++l) {
    bf16_t* w = wb + (size_t)l * WB_LAYER;
    const bool first = (l == 0);
    if ((part == 0) == first) {
      transpose_big<0>(p.w_in + (size_t)l * 1024 * 2816, 1024, 2816, 2816, w + WB_IN, vb, G, smem);
      bf16_t* s = sw + (size_t)l * SW_LAYER;
      transpose_small(p.w2 + (size_t)l * 64 * 384, 64, 384, s + SW_W2, gt, nt);
      transpose_small(p.a2 + (size_t)l * 64 * 384, 64, 384, s + SW_A2, gt, nt);
      transpose_small(p.g2 + (size_t)l * 128 * 384, 128, 384, s + SW_G2, gt, nt);
      for (int g = 0; g < 4; ++g) transpose_small(p.pool_w + (size_t)(l * 4 + g) * 4096, 64, 64, s + SW_POOL + g * 4096, gt, nt);
      if (l == 1) {
        transpose_small(p.v1, 384, 32, s + SW_V1, gt, nt);
        transpose_small(p.v2, 32, 384, s + SW_V2, gt, nt);
      }
    }
    if (part == 1) {
      transpose_big<0>(p.w_out + (size_t)l * 1024 * 1024, 1024, 1024, 1024, w + WB_OUT, vb, G, smem);
      transpose_big<1>(p.w_up + (size_t)l * 1024 * 5632, 1024, 5632, 5632, w + WB_UP, vb, G, smem);
      transpose_big<0>(p.w_down + (size_t)l * 2816 * 1024, 2816, 1024, 1024, w + WB_DOWN, vb, G, smem);
    }
  }
}

__device__ void norm_phase(const float* x, const float* __restrict__ g, bf16_t* h, int gw, int nw) {
  const int lane = otid() & 63;
  for (int row = gw; row < M_; row += nw) {
    const float4* xr = (const float4*)(x + (size_t)row * 1024);
    float4 v[4]; float ss = 0.f;
#pragma unroll
    for (int i = 0; i < 4; ++i) { v[i] = xr[lane + 64 * i]; ss += v[i].x * v[i].x + v[i].y * v[i].y + v[i].z * v[i].z + v[i].w * v[i].w; }
    ss = wavesum(ss);
    const float rs = rsqrtf(ss * (1.f / 1024.f) + 1e-6f);
#pragma unroll
    for (int i = 0; i < 4; ++i) {
      const float4 gv = ((const float4*)g)[lane + 64 * i];
      *(u32x2*)(h + (size_t)row * 1024 + (lane + 64 * i) * 4) = pack4(v[i].x * rs * gv.x, v[i].y * rs * gv.y, v[i].z * rs * gv.z, v[i].w * rs * gv.w);
    }
  }
}

#define LAS __attribute__((address_space(3)))
__device__ __forceinline__ void stage_rc(int b, int& R, int& C) {
  R = b >> 7; C = (((b >> 4) & 7) ^ (R & 7)) * 8;
}
#define GSTAGE(A_, W_, ao_, wo_, buf, kt) do { const int _wb = __builtin_amdgcn_readfirstlane(tid >> 6) * 1024; _Pragma("unroll") for (int _i = 0; _i < 4; ++_i) { \
    __builtin_amdgcn_global_load_lds((const unsigned*)((A_) + (ao_)[_i] + (kt) * 64), (LAS unsigned*)((LAS unsigned char*)smem + (buf) * 32768 + _wb + _i * 4096), 16, 0, 0); \
    __builtin_amdgcn_global_load_lds((const unsigned*)((W_) + (wo_)[_i] + (kt) * 64), (LAS unsigned*)((LAS unsigned char*)smem + (buf) * 32768 + 16384 + _wb + _i * 4096), 16, 0, 0); } } while (0)
__device__ __forceinline__ void gemm_mainloop(const bf16_t* A, const bf16_t* W, const unsigned (&ao)[4], const unsigned (&wo)[4], int nk, unsigned char* smem, f32x4 (&acc)[4][4]) {
  const int tid = otid(), lane = tid & 63, wave = tid >> 6, wr = wave >> 1, wc = wave & 1, fr = lane & 15, fq = lane >> 4;
  const int foff0 = fr * 128 + ((fq ^ (fr & 7)) << 4), foff1 = fr * 128 + (((4 + fq) ^ (fr & 7)) << 4);
  const int aoff = (wr * 64) * 128, boff = 16384 + (wc * 64) * 128;
  asm volatile("s_waitcnt vmcnt(0)" ::: "memory");
  __syncthreads();
  for (int kt = 0; kt < nk; ++kt) {
    const int cb = kt & 1;
    unsigned char* cur = smem + cb * 32768;
    bf16x8 af[2][4], wf[2][4];
#pragma unroll
    for (int ks = 0; ks < 2; ++ks) {
#pragma unroll
      for (int mt = 0; mt < 4; ++mt) af[ks][mt] = *(const bf16x8*)(cur + aoff + mt * 2048 + (ks ? foff1 : foff0));
#pragma unroll
      for (int nt = 0; nt < 4; ++nt) wf[ks][nt] = *(const bf16x8*)(cur + boff + nt * 2048 + (ks ? foff1 : foff0));
    }
    __builtin_amdgcn_sched_barrier(0);
    if (kt + 1 < nk) GSTAGE(A, W, ao, wo, cb ^ 1, kt + 1);
#pragma unroll
    for (int ks = 0; ks < 2; ++ks) {
#pragma unroll
      for (int nt = 0; nt < 4; ++nt)
#pragma unroll
        for (int mt = 0; mt < 4; ++mt) acc[nt][mt] = MFMA16(wf[ks][nt], af[ks][mt], acc[nt][mt]);
    }
    __builtin_amdgcn_sched_barrier(0);
    asm volatile("s_waitcnt vmcnt(0)" ::: "memory");
    __syncthreads();
  }
}

template <int MODE>
__device__ void gemm_phase(const Params& p, int l, int vb, int G, unsigned char* smem) {
  const int tid = otid(), lane = tid & 63, wave = tid >> 6, wr = wave >> 1, wc = wave & 1, fr = lane & 15, fq = lane >> 4;
  const bf16_t* wbl = (const bf16_t*)(p.ws + OFF_WB) + (size_t)l * WB_LAYER;
  const bf16_t* A; const bf16_t* W; int K, nN, nM, lda;
  if (MODE == 0) { A = (const bf16_t*)(p.ws + OFF_HBUF); W = wbl + WB_IN; K = 1024; nN = 22; nM = 256; lda = 1024; }
  if (MODE == 1) { A = (const bf16_t*)(p.ws + OFF_HBUF); W = wbl + WB_OUT; K = 1024; nN = 8; nM = 256; lda = 1024; }
  if (MODE == 2) { A = (const bf16_t*)(p.ws + OFF_HBUF); W = wbl + WB_UP; K = 1024; nN = 44; nM = 264; lda = 1024; }
  if (MODE == 3) { A = (const bf16_t*)(p.ws + OFF_ACT); W = wbl + WB_DOWN; K = 2816; nN = 8; nM = 256; lda = 2816; }
  const int ntile = nM * nN, nk = K >> 6;
  auto tile_pmn = [&](int tile, int& pm_, int& pn_) { const int grp = tile / (8 * nN), within = tile - grp * (8 * nN); pm_ = grp * 8 + (within & 7); pn_ = within >> 3; };
  auto tile_offs = [&](int pm_, int pn_, unsigned (&ao_)[4], unsigned (&wo_)[4]) {
    int tb_ = 0, ti_ = 0;
    if (MODE == 2) { tb_ = pm_ / 33; ti_ = pm_ - tb_ * 33; }
#pragma unroll
    for (int i = 0; i < 4; ++i) {
      int r, cc; stage_rc(tid * 16 + i * 4096, r, cc);
      unsigned grow;
      if (MODE == 2) { int t = 126 * ti_ - 2 + r; t = t < 0 ? 0 : (t > 4095 ? 4095 : t); grow = (unsigned)(tb_ * 4096 + t); }
      else grow = (unsigned)(pm_ * 128 + r);
      ao_[i] = grow * (unsigned)lda + (unsigned)cc;
      wo_[i] = (unsigned)(pn_ * 128 + r) * (unsigned)K + (unsigned)cc;
    }
  };
  unsigned ao[4], wo[4];
  int pm = 0, pn = 0;
  if (vb < ntile) { tile_pmn(vb, pm, pn); tile_offs(pm, pn, ao, wo); GSTAGE(A, W, ao, wo, 0, 0); }
  for (int tile = vb; tile < ntile; tile += G) {
    const int n0 = pn * 128;
    int tb = 0, ti = 0;
    if (MODE == 2) { tb = pm / 33; ti = pm - tb * 33; }
    f32x4 acc[4][4];
#pragma unroll
    for (int a = 0; a < 4; ++a)
#pragma unroll
      for (int b = 0; b < 4; ++b) acc[a][b] = (f32x4){0.f, 0.f, 0.f, 0.f};
    gemm_mainloop(A, W, ao, wo, nk, smem, acc);
    const int cpm = pm; (void)cpm;
    int npm = 0, npn = 0;
    const bool has_next = (tile + G) < ntile;
    if (has_next) { tile_pmn(tile + G, npm, npn); tile_offs(npm, npn, ao, wo); }
    if (MODE != 2) { if (has_next) GSTAGE(A, W, ao, wo, 0, 0); }

    if (MODE == 0) {
      const int cg = (n0 + wc * 64) >> 6;
#pragma unroll
      for (int mt = 0; mt < 4; ++mt) {
        const int tok = pm * 128 + wr * 64 + mt * 16 + fr;
        const int b = tok >> 12, t = tok & 4095;
        if (cg < 22) {
          bf16_t* d = (bf16_t*)(p.ws + OFF_PROJR) + (size_t)tok * 1408 + cg * 64 + fq * 4;
#pragma unroll
          for (int nt = 0; nt < 4; ++nt) *(u32x2*)(d + nt * 16) = pack4(acc[nt][mt][0], acc[nt][mt][1], acc[nt][mt][2], acc[nt][mt][3]);
        } else if (cg < 34) {
          const bool isq = cg < 28; const int head = isq ? cg - 22 : cg - 28;
          const float* gain = (isq ? p.q_gain : p.k_gain) + l * 64;
          float ss = 0.f;
#pragma unroll
          for (int nt = 0; nt < 4; ++nt)
#pragma unroll
            for (int j = 0; j < 4; ++j) ss += acc[nt][mt][j] * acc[nt][mt][j];
          ss += __shfl_xor(ss, 16); ss += __shfl_xor(ss, 32);
          const float rs = rsqrtf(ss * (1.f / 64.f) + 1e-6f) * (isq ? 0.125f : 1.f);
          bf16_t* d = (bf16_t*)(p.ws + (isq ? OFF_SBQ : OFF_SBK)) + ((size_t)(b * 6 + head) * 4096 + t) * 64 + fq * 4;
#pragma unroll
          for (int nt = 0; nt < 4; ++nt) {
            const float4 gv = *(const float4*)(gain + nt * 16 + fq * 4);
            *(u32x2*)(d + nt * 16) = pack4(acc[nt][mt][0] * rs * gv.x, acc[nt][mt][1] * rs * gv.y, acc[nt][mt][2] * rs * gv.z, acc[nt][mt][3] * rs * gv.w);
          }
        } else if (cg < 40) {
          const int head = cg - 34;
          bf16_t* d = (bf16_t*)(p.ws + OFF_SBVT) + ((size_t)(b * 6 + head) * 64 + fq * 4) * 4096 + t;
#pragma unroll
          for (int nt = 0; nt < 4; ++nt)
#pragma unroll
            for (int j = 0; j < 4; ++j) d[(size_t)(nt * 16 + j) * 4096] = f2bf(acc[nt][mt][j]);
        } else {
          bf16_t* d = (bf16_t*)(p.ws + OFF_POOL) + (size_t)tok * 256 + (cg - 40) * 64 + fq * 4;
#pragma unroll
          for (int nt = 0; nt < 4; ++nt) *(u32x2*)(d + nt * 16) = pack4(acc[nt][mt][0], acc[nt][mt][1], acc[nt][mt][2], acc[nt][mt][3]);
        }
      }
    }
    if (MODE == 1 || MODE == 3) {
      const float* resid = (MODE == 1 && l == 0) ? p.x : p.out;
#pragma unroll
      for (int mh = 0; mh < 2; ++mh) {
        float4 rv[2][4];
#pragma unroll
        for (int m2 = 0; m2 < 2; ++m2) {
          const size_t tok = (size_t)pm * 128 + wr * 64 + (mh * 2 + m2) * 16 + fr;
#pragma unroll
          for (int nt = 0; nt < 4; ++nt) rv[m2][nt] = *(const float4*)(resid + tok * 1024 + n0 + wc * 64 + nt * 16 + fq * 4);
        }
#pragma unroll
        for (int m2 = 0; m2 < 2; ++m2) {
          const int mt = mh * 2 + m2;
          const size_t tok = (size_t)pm * 128 + wr * 64 + mt * 16 + fr;
#pragma unroll
          for (int nt = 0; nt < 4; ++nt) {
            float4 ov; ov.x = rv[m2][nt].x + acc[nt][mt][0]; ov.y = rv[m2][nt].y + acc[nt][mt][1]; ov.z = rv[m2][nt].z + acc[nt][mt][2]; ov.w = rv[m2][nt].w + acc[nt][mt][3];
            *(float4*)(p.out + tok * 1024 + n0 + wc * 64 + nt * 16 + fq * 4) = ov;
          }
        }
      }
    }
    if (MODE == 2) {
      float* halo = (float*)(smem + 32768);
      if (ti == 0 && wr == 0 && fr < 2) {
#pragma unroll
        for (int nt = 0; nt < 4; ++nt) acc[nt][0] = (f32x4){0.f, 0.f, 0.f, 0.f};
      }
      if (wr == 0 && fr >= 14) {
#pragma unroll
        for (int nt = 0; nt < 4; ++nt) *(f32x4*)(halo + (wc * 2 + (fr - 14)) * 64 + nt * 16 + fq * 4) = acc[nt][3];
      }
      __syncthreads();
      f32x4 xm1[4];
#pragma unroll
      for (int nt = 0; nt < 4; ++nt) {
        xm1[nt] = (f32x4){0.f, 0.f, 0.f, 0.f};
        if (wr == 1 && fr >= 14) xm1[nt] = *(const f32x4*)(halo + (wc * 2 + (fr - 14)) * 64 + nt * 16 + fq * 4);
      }
      __syncthreads();
      if (has_next) GSTAGE(A, W, ao, wo, 0, 0);
      const int Gc = (n0 + wc * 64) >> 6;
      const float* cw = p.conv_w + (size_t)l * 3 * 5632;
      const float* cb = p.conv_b + (size_t)l * 5632;
      bf16_t* actp = (bf16_t*)(p.ws + OFF_ACT);
#pragma unroll
      for (int nt = 0; nt < 2; ++nt) {
        const int ch = 32 * Gc + nt * 16 + fq * 4;
        const float4 cbg = *(const float4*)(cb + ch), cbv = *(const float4*)(cb + 2816 + ch);
        float4 cwg[3], cwv[3];
#pragma unroll
        for (int i = 0; i < 3; ++i) { cwg[i] = *(const float4*)(cw + i * 5632 + ch); cwv[i] = *(const float4*)(cw + i * 5632 + 2816 + ch); }
#pragma unroll
        for (int mt = 0; mt < 4; ++mt) {
          const int rt = wr * 64 + mt * 16 + fr;
          const int t = 126 * ti - 2 + rt;
          const bool valid = (rt >= 2) && (t < 4096);
          float o[4];
#pragma unroll
          for (int j = 0; j < 4; ++j) {
            float cvv[2];
#pragma unroll
            for (int gvi = 0; gvi < 2; ++gvi) {
              const int n2 = nt + 2 * gvi;
              const float x0 = acc[n2][mt][j];
              const float xp = (mt == 0) ? xm1[n2][j] : acc[n2][mt == 0 ? 0 : mt - 1][j];
              const float p1 = dppf<0x121>((fr == 15) ? xp : x0);
              const float p2 = dppf<0x122>((fr >= 14) ? xp : x0);
              const float4* wv = gvi ? cwv : cwg;
              const float bias = gvi ? ((const float*)&cbv)[j] : ((const float*)&cbg)[j];
              cvv[gvi] = bias + ((const float*)&wv[0])[j] * p2 + ((const float*)&wv[1])[j] * p1 + ((const float*)&wv[2])[j] * x0;
            }
            o[j] = cvv[0] * sigmoidf_(cvv[0]) * cvv[1];
          }
          if (valid) *(u32x2*)(actp + ((size_t)tb * 4096 + t) * 2816 + ch) = pack4(o[0], o[1], o[2], o[3]);
        }
      }
    }
    pm = npm; pn = npn;
  }
#undef GSTAGE
}

__device__ void rwkv_prep_task(const Params& p, int l, int tok0, unsigned char* smem) {
  const int lane = otid() & 63, fr = lane & 15, fq = lane >> 4;
  const int tok = tok0 + fr, t = tok & 4095;
  const bool hasprev = t > 0;
  const bf16_t* cur = (const bf16_t*)(p.ws + OFF_PROJR) + (size_t)tok * 1408;
  const bf16_t* prv = cur - (hasprev ? 1408 : 0);
  const float* mu = p.mu + l * 1408;
  const bf16_t* sw = (const bf16_t*)(p.ws + OFF_SMALLW) + (size_t)l * SW_LAYER;
  auto shift8 = [&](int c, float* o) {
    u32x4 uc = *(const u32x4*)(cur + c); u32x4 up = *(const u32x4*)(prv + c);
    float fc[8], fp[8]; unpack8(uc, fc); unpack8(up, fp);
    const float4 m0 = *(const float4*)(mu + c), m1 = *(const float4*)(mu + c + 4);
    const float m[8] = {m0.x, m0.y, m0.z, m0.w, m1.x, m1.y, m1.z, m1.w};
#pragma unroll
    for (int i = 0; i < 8; ++i) { const float pv = hasprev ? fp[i] : 0.f; o[i] = fc[i] + (pv - fc[i]) * m[i]; }
  };
  auto shift4 = [&](int c, float* o) {
    u32x2 uc = *(const u32x2*)(cur + c); u32x2 up = *(const u32x2*)(prv + c);
    float fc[4], fp[4]; unpack4(uc, fc); unpack4(up, fp);
    const float4 m0 = *(const float4*)(mu + c);
    const float m[4] = {m0.x, m0.y, m0.z, m0.w};
#pragma unroll
    for (int i = 0; i < 4; ++i) { const float pv = hasprev ? fp[i] : 0.f; o[i] = fc[i] + (pv - fc[i]) * m[i]; }
  };
  bf16x8 Bw[2], Ba[2], Bg[4], Bu;
  {
    float o[8];
#pragma unroll
    for (int ks = 0; ks < 2; ++ks) {
      shift8(1152 + ks * 32 + fq * 8, o);
#pragma unroll
      for (int i = 0; i < 8; ++i) o[i] = tanhf_(o[i]);
      Bw[ks] = pack8(o);
      shift8(1216 + ks * 32 + fq * 8, o);
      Ba[ks] = pack8(o);
    }
#pragma unroll
    for (int ks = 0; ks < 4; ++ks) {
      shift8(1280 + ks * 32 + fq * 8, o);
#pragma unroll
      for (int i = 0; i < 8; ++i) o[i] = sigmoidf_(o[i]);
      Bg[ks] = pack8(o);
    }
  }
  if (l == 1) {
    f32x4 u0 = {0.f, 0.f, 0.f, 0.f}, u1 = {0.f, 0.f, 0.f, 0.f};
    const bf16_t* v1t = sw + SW_V1;
#pragma unroll 2
    for (int ks = 0; ks < 12; ++ks) {
      float o[8]; shift8(768 + ks * 32 + fq * 8, o);
      const bf16x8 bv = pack8(o);
      const bf16x8 a0 = *(const bf16x8*)(v1t + (size_t)fr * 384 + ks * 32 + fq * 8);
      const bf16x8 a1 = *(const bf16x8*)(v1t + (size_t)(16 + fr) * 384 + ks * 32 + fq * 8);
      u0 = MFMA16(a0, bv, u0); u1 = MFMA16(a1, bv, u1);
    }
    const float uu[8] = {u0[0], u0[1], u0[2], u0[3], u1[0], u1[1], u1[2], u1[3]};
    Bu = pack8(uu);
  }
  const float* w0 = p.w0 + l * 384; const float* a0p = p.a0 + l * 384; const float* kkp = p.k_k + l * 384; const float* kap = p.k_a + l * 384;
  const float* rkp = p.r_k + l * 384; const float* v0p = p.v0;
  bf16_t* SR = (bf16_t*)(p.ws + OFF_SR); bf16_t* SK = (bf16_t*)(p.ws + OFF_SK); bf16_t* SV = (bf16_t*)(p.ws + OFF_SV);
  bf16_t* SA = (bf16_t*)(p.ws + OFF_SA); bf16_t* SBp = (bf16_t*)(p.ws + OFF_SB); bf16_t* Gp = (bf16_t*)(p.ws + OFF_G);
  bf16_t* VF = (bf16_t*)(p.ws + OFF_VFIRST); float* SWp = (float*)(p.ws + OFF_SW); float* bonus = (float*)(p.ws + OFF_BONUS);
  const int stid = otid();
#pragma unroll 1
  for (int h = 0; h < 6; ++h) {
    __syncthreads();
    {
      u32x4 t0, t1, t2, t3;
      { const int q0 = stid, q1 = stid + 256;
        t0 = *(const u32x4*)(sw + SW_W2 + (size_t)(h * 64 + (q0 >> 3)) * 64 + (q0 & 7) * 8); t1 = *(const u32x4*)(sw + SW_W2 + (size_t)(h * 64 + (q1 >> 3)) * 64 + (q1 & 7) * 8);
        t2 = *(const u32x4*)(sw + SW_A2 + (size_t)(h * 64 + (q0 >> 3)) * 64 + (q0 & 7) * 8); t3 = *(const u32x4*)(sw + SW_A2 + (size_t)(h * 64 + (q1 >> 3)) * 64 + (q1 & 7) * 8);
        *(u32x4*)(smem + (q0 >> 3) * 144 + (q0 & 7) * 16) = t0; *(u32x4*)(smem + (q1 >> 3) * 144 + (q1 & 7) * 16) = t1;
        *(u32x4*)(smem + 9216 + (q0 >> 3) * 144 + (q0 & 7) * 16) = t2; *(u32x4*)(smem + 9216 + (q1 >> 3) * 144 + (q1 & 7) * 16) = t3; }
      __builtin_amdgcn_sched_barrier(0);
      { const int q0 = stid, q1 = stid + 256, q2 = stid + 512, q3 = stid + 768;
        t0 = *(const u32x4*)(sw + SW_G2 + (size_t)(h * 64 + (q0 >> 4)) * 128 + (q0 & 15) * 8); t1 = *(const u32x4*)(sw + SW_G2 + (size_t)(h * 64 + (q1 >> 4)) * 128 + (q1 & 15) * 8);
        t2 = *(const u32x4*)(sw + SW_G2 + (size_t)(h * 64 + (q2 >> 4)) * 128 + (q2 & 15) * 8); t3 = *(const u32x4*)(sw + SW_G2 + (size_t)(h * 64 + (q3 >> 4)) * 128 + (q3 & 15) * 8);
        *(u32x4*)(smem + 18432 + (q0 >> 4) * 272 + (q0 & 15) * 16) = t0; *(u32x4*)(smem + 18432 + (q1 >> 4) * 272 + (q1 & 15) * 16) = t1;
        *(u32x4*)(smem + 18432 + (q2 >> 4) * 272 + (q2 & 15) * 16) = t2; *(u32x4*)(smem + 18432 + (q3 >> 4) * 272 + (q3 & 15) * 16) = t3; }
    }
    __syncthreads();
    const int cb = h * 64 + 8 * fq;
    __builtin_amdgcn_sched_barrier(0);
    float ss = 0.f;
    {
      float k16[16];
      shift8(384 + cb, k16); shift8(384 + cb + 32, k16 + 8);
#pragma unroll
      for (int q = 0; q < 4; ++q) {
        const float4 kkv = *(const float4*)(kkp + cb + 32 * (q >> 1) + 4 * (q & 1));
        const float x0 = k16[4 * q] * kkv.x, x1 = k16[4 * q + 1] * kkv.y, x2 = k16[4 * q + 2] * kkv.z, x3 = k16[4 * q + 3] * kkv.w;
        ss += x0 * x0 + x1 * x1 + x2 * x2 + x3 * x3;
      }
    }
    ss += __shfl_xor(ss, 16); ss += __shfl_xor(ss, 32);
    const float inv = 1.f / fmaxf(sqrtf(ss), 1e-12f);
    float bsum = 0.f;
#pragma unroll 1
    for (int half = 0; half < 2; ++half) {
      f32x4 lw[2], la[2], lg[2], lv[2];
#pragma unroll
      for (int n2 = 0; n2 < 2; ++n2) {
        const int nt = 2 * half + n2;
        lw[n2] = (f32x4){0.f, 0.f, 0.f, 0.f}; la[n2] = lw[n2]; lg[n2] = lw[n2]; lv[n2] = lw[n2];
        const int rloc = 32 * half + 8 * (fr >> 2) + 4 * n2 + (fr & 3);
        const int crow = h * 64 + rloc;
#pragma unroll
        for (int ks = 0; ks < 2; ++ks) {
          lw[n2] = MFMA16(*(const bf16x8*)(smem + rloc * 144 + (ks * 4 + fq) * 16), Bw[ks], lw[n2]);
          la[n2] = MFMA16(*(const bf16x8*)(smem + 9216 + rloc * 144 + (ks * 4 + fq) * 16), Ba[ks], la[n2]);
        }
#pragma unroll
        for (int ks = 0; ks < 4; ++ks) lg[n2] = MFMA16(*(const bf16x8*)(smem + 18432 + rloc * 272 + (ks * 4 + fq) * 16), Bg[ks], lg[n2]);
        if (l == 1) {
          const u32x2 lo = *(const u32x2*)(sw + SW_V2 + (size_t)crow * 32 + 4 * fq);
          const u32x2 hi = *(const u32x2*)(sw + SW_V2 + (size_t)crow * 32 + 16 + 4 * fq);
          u32x4 av = {lo.x, lo.y, hi.x, hi.y};
          lv[n2] = MFMA16(*reinterpret_cast<bf16x8*>(&av), Bu, lv[n2]);
        }
      }
      const int c8 = cb + 32 * half;
      const size_t o = (size_t)tok * 384 + c8;
      float r8[8], v8[8], k8[8], w0a[8], a0a[8], kaa[8], rka[8], kka[8];
      shift8(c8, r8); shift8(768 + c8, v8); shift8(384 + c8, k8);
#pragma unroll
      for (int q = 0; q < 2; ++q) {
        const float4 t0 = *(const float4*)(w0 + c8 + 4 * q), t1 = *(const float4*)(a0p + c8 + 4 * q), t2 = *(const float4*)(kap + c8 + 4 * q), t3 = *(const float4*)(rkp + c8 + 4 * q);
        const float4 t4 = *(const float4*)(kkp + c8 + 4 * q);
        kka[4 * q] = t4.x; kka[4 * q + 1] = t4.y; kka[4 * q + 2] = t4.z; kka[4 * q + 3] = t4.w;
        w0a[4 * q] = t0.x; w0a[4 * q + 1] = t0.y; w0a[4 * q + 2] = t0.z; w0a[4 * q + 3] = t0.w;
        a0a[4 * q] = t1.x; a0a[4 * q + 1] = t1.y; a0a[4 * q + 2] = t1.z; a0a[4 * q + 3] = t1.w;
        kaa[4 * q] = t2.x; kaa[4 * q + 1] = t2.y; kaa[4 * q + 2] = t2.z; kaa[4 * q + 3] = t2.w;
        rka[4 * q] = t3.x; rka[4 * q + 1] = t3.y; rka[4 * q + 2] = t3.z; rka[4 * q + 3] = t3.w;
      }
      if (l == 1) {
        float vf[8], v0a[8]; unpack8(*(const u32x4*)(VF + o), vf);
        const float4 t0 = *(const float4*)(v0p + c8), t1 = *(const float4*)(v0p + c8 + 4);
        v0a[0] = t0.x; v0a[1] = t0.y; v0a[2] = t0.z; v0a[3] = t0.w; v0a[4] = t1.x; v0a[5] = t1.y; v0a[6] = t1.z; v0a[7] = t1.w;
#pragma unroll
        for (int e8 = 0; e8 < 8; ++e8) v8[e8] = v8[e8] + (vf[e8] - v8[e8]) * sigmoidf_(v0a[e8] + lv[e8 >> 2][e8 & 3]);
      } else {
        *(bf16x8*)(VF + o) = pack8(v8);
      }
      float dec[8], kf[8], an[8], bn[8], gg[8];
#pragma unroll
      for (int e8 = 0; e8 < 8; ++e8) {
        const int nt = e8 >> 2, j = e8 & 3, e = 8 * half + e8;
        dec[e8] = __expf(-0.60653066f * sigmoidf_(w0a[e8] + lw[nt][j]));
        const float sa = sigmoidf_(a0a[e8] + la[nt][j]);
        const float kn = k8[e8] * kka[e8] * inv;
        an[e8] = -kn; bn[e8] = kn * sa;
        kf[e8] = k8[e8] * (1.f + (sa - 1.f) * kaa[e8]);
        bsum += r8[e8] * kf[e8] * rka[e8];
        gg[e8] = lg[nt][j];
      }
      *(float4*)(SWp + o) = make_float4(dec[0], dec[1], dec[2], dec[3]); *(float4*)(SWp + o + 4) = make_float4(dec[4], dec[5], dec[6], dec[7]);
      *(bf16x8*)(SR + o) = pack8(r8);
      *(bf16x8*)(SK + o) = pack8(kf);
      *(bf16x8*)(SV + o) = pack8(v8);
      *(bf16x8*)(Gp + o) = pack8(gg);
      *(bf16x8*)(SA + o) = pack8(an);
      *(bf16x8*)(SBp + o) = pack8(bn);
    }
    bsum += __shfl_xor(bsum, 16); bsum += __shfl_xor(bsum, 32);
    if (fq == 0) bonus[(size_t)tok * 6 + h] = bsum;
  }
}

__device__ void pool_task(const Params& p, int l, int tok0) {
  const int lane = otid() & 63, fr = lane & 15, fq = lane >> 4;
  const int tok = tok0 + fr, t = tok & 4095;
  const bf16_t* u = (const bf16_t*)(p.ws + OFF_POOL) + (size_t)tok * 256;
  const bf16_t* pt = (const bf16_t*)(p.ws + OFF_SMALLW) + (size_t)l * SW_LAYER + SW_POOL;
  bf16_t* mix = (bf16_t*)(p.ws + OFF_HBUF);
#pragma unroll
  for (int g = 0; g < 4; ++g) {
    const int w = 2 << g;
    const int cnt = (t + 1) < w ? (t + 1) : w;
    const float icnt = 1.f / (float)cnt;
    bf16x8 B[2];
#pragma unroll
    for (int ks = 0; ks < 2; ++ks) {
      const int c = g * 64 + ks * 32 + fq * 8;
      float s[8], f[8], u0[8];
      unpack8(*(const u32x4*)(u + c), u0);
#pragma unroll
      for (int i = 0; i < 8; ++i) s[i] = u0[i];
#pragma unroll
      for (int d0 = 1; d0 < w; d0 += 8) {
        u32x4 wr_[8];
#pragma unroll
        for (int q = 0; q < 8; ++q) { const int d = d0 + q; if (d < w) { const int dd = d < cnt ? d : 0; wr_[q] = *(const u32x4*)(u + c - (size_t)dd * 256); } }
#pragma unroll
        for (int q = 0; q < 8; ++q) { const int d = d0 + q; if (d < w) { unpack8(wr_[q], f);
#pragma unroll
          for (int i = 0; i < 8; ++i) s[i] += (d < cnt) ? f[i] : 0.f; } }
      }
#pragma unroll
      for (int i = 0; i < 8; ++i) s[i] = s[i] * icnt - u0[i];
      B[ks] = pack8(s);
    }
    float yo[16];
#pragma unroll
    for (int nt = 0; nt < 4; ++nt) {
      f32x4 acc = {0.f, 0.f, 0.f, 0.f};
      const int drow = 32 * (nt >> 1) + 8 * (fr >> 2) + 4 * (nt & 1) + (fr & 3);
#pragma unroll
      for (int ks = 0; ks < 2; ++ks) acc = MFMA16(*(const bf16x8*)(pt + (size_t)g * 4096 + (size_t)drow * 64 + ks * 32 + fq * 8), B[ks], acc);
      const int d = 32 * (nt >> 1) + 8 * fq + 4 * (nt & 1);
      const float4 bv = *(const float4*)(p.pool_b + (size_t)(l * 4 + g) * 64 + d);
      const float4 sv = *(const float4*)(p.pool_scale + (size_t)l * 256 + g * 64 + d);
      yo[4 * nt] = (acc[0] + bv.x) * sv.x; yo[4 * nt + 1] = (acc[1] + bv.y) * sv.y; yo[4 * nt + 2] = (acc[2] + bv.z) * sv.z; yo[4 * nt + 3] = (acc[3] + bv.w) * sv.w;
    }
    *(bf16x8*)(mix + (size_t)tok * 1024 + 768 + g * 64 + 8 * fq) = pack8(yo);
    *(bf16x8*)(mix + (size_t)tok * 1024 + 768 + g * 64 + 32 + 8 * fq) = pack8(yo + 8);
  }
}

__device__ void scan_block(const Params& p, int sb, unsigned char* smem) {
  const int tid = otid(), lane = tid & 63, wave = tid >> 6, rr = lane >> 4, c = lane & 15;
  const int bh = sb >> 2, rq = sb & 3, b = bh / 6, h = bh - b * 6;
  const int rloc = wave * 4 + rr;
  const int row = rq * 16 + rloc;
  const size_t base = (size_t)b * 4096 * 384 + h * 64;
  const bf16_t* SR = (const bf16_t*)(p.ws + OFF_SR); const bf16_t* SK = (const bf16_t*)(p.ws + OFF_SK); const bf16_t* SV = (const bf16_t*)(p.ws + OFF_SV);
  const bf16_t* SA = (const bf16_t*)(p.ws + OFF_SA); const bf16_t* SBp = (const bf16_t*)(p.ws + OFF_SB); const float* SWp = (const float*)(p.ws + OFF_SW);
  float* Y = (float*)(p.ws + OFF_PROJR);
  float* lds = (float*)smem;
  constexpr int STEP = 336, BUF = 16 * STEP;
  const int q0 = tid, q1 = tid + 256;
  const int arr0 = q0 >> 7, st0 = (q0 & 127) >> 3, pt0 = q0 & 7;
  const int arr1 = q1 >> 7, st1 = (q1 & 127) >> 3, pt1 = q1 & 7;
  const bf16_t* src0 = (arr0 == 0 ? SA : SBp) + base + (size_t)st0 * 384 + pt0 * 8;
  const bf16_t* src1 = (arr1 == 2 ? SK : SR) + base + (size_t)st1 * 384 + pt1 * 8;
  const int slot0 = (arr0 == 0 ? 0 : 64), slot1 = (arr1 == 2 ? 192 : 256);
  const int stw = tid >> 4, ptw = tid & 15;
  const float* srcw = SWp + base + (size_t)stw * 384 + ptw * 4;
  const int stv = (tid & 63) >> 2, ptv = tid & 3;
  const bf16_t* srcv = SV + base + (size_t)stv * 384 + rq * 16 + ptv * 4;
  u32x4 g0, g1; float4 gw; u32x2 gv = {0u, 0u};
  auto gload = [&](int ch) {
    const size_t o = (size_t)ch * 16 * 384;
    g0 = *(const u32x4*)(src0 + o); g1 = *(const u32x4*)(src1 + o); gw = *(const float4*)(srcw + o);
    if (tid < 64) gv = *(const u32x2*)(srcv + o);
  };
  auto lwrite = [&](int bufi) {
    float* L = lds + bufi * BUF;
    float f[8];
    unpack8(g0, f);
    *(float4*)(L + st0 * STEP + slot0 + pt0 * 8) = make_float4(f[0], f[1], f[2], f[3]); *(float4*)(L + st0 * STEP + slot0 + pt0 * 8 + 4) = make_float4(f[4], f[5], f[6], f[7]);
    unpack8(g1, f);
    *(float4*)(L + st1 * STEP + slot1 + pt1 * 8) = make_float4(f[0], f[1], f[2], f[3]); *(float4*)(L + st1 * STEP + slot1 + pt1 * 8 + 4) = make_float4(f[4], f[5], f[6], f[7]);
    *(float4*)(L + stw * STEP + 128 + ptw * 4) = gw;
    if (tid < 64) { float v4[4]; unpack4(gv, v4); *(float4*)(L + stv * STEP + 320 + ptv * 4) = make_float4(v4[0], v4[1], v4[2], v4[3]); }
  };
  f32x2_t s01 = {0.f, 0.f}, s23 = {0.f, 0.f};
  gload(0); lwrite(0);
  __syncthreads();
  f32x4 qA[2][2], qB[2][2], qW[2][2], qK[2][2], qR[2][2]; float qv[2][2];
#define SLOAD(set, Lp, g) do { _Pragma("unroll") for (int _u = 0; _u < 2; ++_u) { const float* _Ls = (Lp) + ((g) * 2 + _u) * STEP; \
    qA[set][_u] = *(const f32x4*)(_Ls + 4 * c); qB[set][_u] = *(const f32x4*)(_Ls + 64 + 4 * c); qW[set][_u] = *(const f32x4*)(_Ls + 128 + 4 * c); \
    qK[set][_u] = *(const f32x4*)(_Ls + 192 + 4 * c); qR[set][_u] = *(const f32x4*)(_Ls + 256 + 4 * c); qv[set][_u] = _Ls[320 + rloc]; } } while (0)
#define SSTEP(set, u, stidx) do { \
    const f32x4 A = qA[set][u], Bv = qB[set][u], W = qW[set][u], Kv = qK[set][u], R = qR[set][u]; const float v = qv[set][u]; \
    const f32x2_t vv = {v, v}; \
    const f32x2_t A01 = {A[0], A[1]}, A23 = {A[2], A[3]}, B01 = {Bv[0], Bv[1]}, B23 = {Bv[2], Bv[3]}, W01 = {W[0], W[1]}, W23 = {W[2], W[3]}; \
    const f32x2_t K01 = {Kv[0], Kv[1]}, K23 = {Kv[2], Kv[3]}, R01 = {R[0], R[1]}, R23 = {R[2], R[3]}; \
    const f32x2_t pd2 = s01 * A01 + s23 * A23; \
    const f32x2_t t01 = s01 * W01 + vv * K01, t23 = s23 * W23 + vv * K23; \
    const float pdot = rowsum16(pd2[0] + pd2[1]); \
    const f32x2_t pp = {pdot, pdot}; \
    s01 = pp * B01 + t01; s23 = pp * B23 + t23; \
    const f32x2_t y2 = s01 * R01 + s23 * R23; \
    yp[stidx] = y2[0] + y2[1]; } while (0)
  for (int ch = 0; ch < 256; ++ch) {
    const float* L = lds + (ch & 1) * BUF;
    if (ch + 1 < 256) gload(ch + 1);
    float yp[16];
    SLOAD(0, L, 0);
#pragma unroll
    for (int g = 0; g < 8; g += 2) {
      SLOAD(1, L, g + 1);
      SSTEP(0, 0, g * 2); SSTEP(0, 1, g * 2 + 1);
      if (g + 2 < 8) SLOAD(0, L, g + 2);
      SSTEP(1, 0, g * 2 + 2); SSTEP(1, 1, g * 2 + 3);
    }
    float ykeep;
    {
      const bool m8 = (c & 8) != 0, m4 = (c & 4) != 0, m2 = (c & 2) != 0, m1 = (c & 1) != 0;
      float r8[8], r4[4], r2[2];
#pragma unroll
      for (int i = 0; i < 8; ++i) { const float keep = m8 ? yp[i + 8] : yp[i], send = m8 ? yp[i] : yp[i + 8]; r8[i] = keep + dppf<0x140>(send); }
#pragma unroll
      for (int i = 0; i < 4; ++i) { const float keep = m4 ? r8[i + 4] : r8[i], send = m4 ? r8[i] : r8[i + 4]; r4[i] = keep + dppf<0x141>(send); }
#pragma unroll
      for (int i = 0; i < 2; ++i) { const float keep = m2 ? r4[i + 2] : r4[i], send = m2 ? r4[i] : r4[i + 2]; r2[i] = keep + dppf<0x4E>(send); }
      { const float keep = m1 ? r2[1] : r2[0], send = m1 ? r2[0] : r2[1]; ykeep = keep + dppf<0xB1>(send); }
    }
    Y[base + (size_t)(ch * 16 + c) * 384 + row] = ykeep;
    if (ch + 1 < 256) lwrite((ch + 1) & 1);
    __syncthreads();
  }
#undef SLOAD
#undef SSTEP
}

__device__ void attn_task(const Params& p, int task) {
  const int lane = otid() & 63, r = lane & 31, hh = lane >> 5;
  const int bh = task >> 7, qt = 127 - (task & 127);
  const int b = bh / 6, h = bh - b * 6;
  const int t0 = qt * 32;
  const bf16_t* sbq = (const bf16_t*)(p.ws + OFF_SBQ); const bf16_t* sbk = (const bf16_t*)(p.ws + OFF_SBK); const bf16_t* sbvt = (const bf16_t*)(p.ws + OFF_SBVT);
  bf16x8 qf[4];
  {
    const bf16_t* qb = sbq + ((size_t)bh * 4096 + t0 + r) * 64 + 8 * hh;
#pragma unroll
    for (int ks = 0; ks < 4; ++ks) qf[ks] = *(const bf16x8*)(qb + 16 * ks);
  }
  f32x16 o0, o1;
#pragma unroll
  for (int i = 0; i < 16; ++i) { o0[i] = 0.f; o1[i] = 0.f; }
  float crun = 0.f;
  for (int kb = qt; kb >= 0; --kb) {
    const bf16_t* kp = sbk + ((size_t)bh * 4096 + kb * 32 + r) * 64 + 8 * hh;
    f32x16 s;
#pragma unroll
    for (int i = 0; i < 16; ++i) s[i] = 0.f;
#pragma unroll
    for (int ks = 0; ks < 4; ++ks) s = MFMA32(*(const bf16x8*)(kp + 16 * ks), qf[ks], s);
    const bool diag = (kb == qt);
    float C[16], tg[4], ptn[4], both[4], suf[4];
    bool cz[16];
#pragma unroll
    for (int g = 0; g < 4; ++g) {
      float run = 0.f;
#pragma unroll
      for (int i = 3; i >= 0; --i) {
        const int reg = 4 * g + i;
        const int key = i + 8 * g + 4 * hh;
        const bool causal = (!diag) || (key < r);
        cz[reg] = causal;
        const float L = causal ? -softplusf_(s[reg]) : 0.f;
        run += L;
        C[reg] = run;
      }
      tg[g] = run;
    }
#pragma unroll
    for (int g = 0; g < 4; ++g) { ptn[g] = __shfl_xor(tg[g], 32); both[g] = tg[g] + ptn[g]; }
    suf[3] = 0.f; suf[2] = both[3]; suf[1] = suf[2] + both[2]; suf[0] = suf[1] + both[1];
    float A[16];
#pragma unroll
    for (int g = 0; g < 4; ++g) {
      const float off = suf[g] + (hh == 0 ? ptn[g] : 0.f) + crun;
#pragma unroll
      for (int i = 0; i < 4; ++i) { const int reg = 4 * g + i; A[reg] = cz[reg] ? __expf(s[reg] + C[reg] + off) : 0.f; }
    }
    crun += suf[0] + both[0];
#pragma unroll
    for (int s2 = 0; s2 < 2; ++s2) {
      const bf16x8 pf = pack8(&A[8 * s2]);
      {
        const bf16_t* vp = sbvt + ((size_t)bh * 64 + r) * 4096 + kb * 32 + 16 * s2 + 4 * hh;
        const u32x2 lo = *(const u32x2*)vp, hi = *(const u32x2*)(vp + 8);
        u32x4 vv = {lo.x, lo.y, hi.x, hi.y};
        o0 = MFMA32(pf, *reinterpret_cast<bf16x8*>(&vv), o0);
      }
      {
        const bf16_t* vp = sbvt + ((size_t)bh * 64 + 32 + r) * 4096 + kb * 32 + 16 * s2 + 4 * hh;
        const u32x2 lo = *(const u32x2*)vp, hi = *(const u32x2*)(vp + 8);
        u32x4 vv = {lo.x, lo.y, hi.x, hi.y};
        o1 = MFMA32(pf, *reinterpret_cast<bf16x8*>(&vv), o1);
      }
    }
    if (__ballot(crun >= -110.f) == 0ull) break;
  }
  bf16_t* mix = (bf16_t*)(p.ws + OFF_HBUF);
#pragma unroll
  for (int reg = 0; reg < 16; ++reg) {
    const int q = (reg & 3) + 8 * (reg >> 2) + 4 * hh;
    bf16_t* d = mix + ((size_t)b * 4096 + t0 + q) * 1024 + 384 + h * 64 + r;
    d[0] = f2bf(o0[reg]); d[32] = f2bf(o1[reg]);
  }
}

__device__ void post_phase(const Params& p, int l, int gt, int nt) {
  const float* Y = (const float*)(p.ws + OFF_PROJR); const bf16_t* SV = (const bf16_t*)(p.ws + OFF_SV); const bf16_t* Gp = (const bf16_t*)(p.ws + OFF_G);
  const float* bonus = (const float*)(p.ws + OFF_BONUS);
  bf16_t* mix = (bf16_t*)(p.ws + OFF_HBUF);
  const int total = M_ * 96;
  for (int i = gt; i < total; i += nt) {
    const int tok = i / 96, cgp = i - tok * 96, c = cgp * 4, h = cgp >> 4;
    const size_t o = (size_t)tok * 384 + c;
    const float4 y = *(const float4*)(Y + o);
    float v4[4], g4[4]; unpack4(*(const u32x2*)(SV + o), v4); unpack4(*(const u32x2*)(Gp + o), g4);
    const float mean = rowsum16((y.x + y.y) + (y.z + y.w)) * (1.f / 64.f);
    const float d0 = y.x - mean, d1 = y.y - mean, d2 = y.z - mean, d3 = y.w - mean;
    const float var = rowsum16((d0 * d0 + d1 * d1) + (d2 * d2 + d3 * d3)) * (1.f / 64.f);
    const float rs = rsqrtf(var + 64e-5f);
    const float4 lw = *(const float4*)(p.lnx_w + l * 384 + c), lb = *(const float4*)(p.lnx_b + l * 384 + c);
    const float bo = bonus[(size_t)tok * 6 + h];
    *(u32x2*)(mix + (size_t)tok * 1024 + c) = pack4((d0 * rs * lw.x + lb.x + bo * v4[0]) * g4[0], (d1 * rs * lw.y + lb.y + bo * v4[1]) * g4[1],
                                                    (d2 * rs * lw.z + lb.z + bo * v4[2]) * g4[2], (d3 * rs * lw.w + lb.w + bo * v4[3]) * g4[3]);
  }
}

__global__ void __launch_bounds__(256, 2) fwd_megakernel(Params p) {
  __shared__ __attribute__((aligned(16))) unsigned char smem[65536];
  GridBar gb; gb.bar = (unsigned*)(p.ws + OFF_BAR); gb.nloc = 0u; gb.nx = 0u;
  gb.x = (unsigned)__builtin_amdgcn_s_getreg((3 << 11) | 20) & 0xFu;
  if (threadIdx.x == 0) (void)xb_add(&gb.bar[XB_XCNT(gb.x)], 1u);
  const int bid = blockIdx.x, G = gridDim.x;
#define wave (otid() >> 6)
#define gw (bid * 4 + (otid() >> 6))
#define gt (bid * 256 + otid())
  const int vb = (bid & 7) * (G >> 3) + (bid >> 3);
  const int nw = G * 4, ngt = G * 256;
  bf16_t* hbuf = (bf16_t*)(p.ws + OFF_HBUF);

  prep_phase(p, 0, vb, G, gt, ngt, smem);
  norm_phase(p.x, p.ln1_g, hbuf, gw, nw);
  grid_barrier(gb);
#pragma unroll 1
  for (int l = 0; l < 2; ++l) {
    if (l > 0) { norm_phase(p.out, p.ln1_g + 1024, hbuf, gw, nw); grid_barrier(gb); }
    gemm_phase<0>(p, l, vb, G, smem);
    grid_barrier(gb);
    for (int blk = bid; blk < 512; blk += G) rwkv_prep_task(p, l, (blk * 4 + wave) * 16, smem);
    grid_barrier(gb);
    if (bid < 192) scan_block(p, bid, smem);
    else {
      for (int task = (bid - 192) * 4 + wave; task < 6144; task += (G - 192) * 4) attn_task(p, task);
      for (int task = (bid - 192) * 4 + wave; task < 2048; task += (G - 192) * 4) pool_task(p, l, task * 16);
      if (l == 0) { __syncthreads(); prep_phase(p, 1, bid - 192, G - 192, (bid - 192) * 256 + otid(), (G - 192) * 256, smem); }
    }
    grid_barrier(gb);
    post_phase(p, l, gt, ngt);
    grid_barrier(gb);
    gemm_phase<1>(p, l, vb, G, smem);
    grid_barrier(gb);
    norm_phase(p.out, p.ln2_g + l * 1024, hbuf, gw, nw);
    grid_barrier(gb);
    gemm_phase<2>(p, l, vb, G, smem);
    grid_barrier(gb);
    gemm_phase<3>(p, l, vb, G, smem);
    if (l == 0) grid_barrier(gb);
  }
}

#undef wave
#undef gw
#undef gt

extern "C" void kernel_launch(void* const* d_in, const int* in_sizes, int n_in, void* d_out, int out_size, void* d_ws, size_t ws_size, hipStream_t stream) {
  static int grid_blocks = 0;
  if (!grid_blocks) {
    int dev = 0, cus = 0, per_cu = 0;
    (void)hipGetDevice(&dev);
    (void)hipDeviceGetAttribute(&cus, hipDeviceAttributeMultiprocessorCount, dev);
    (void)hipOccupancyMaxActiveBlocksPerMultiprocessor(&per_cu, fwd_megakernel, 256, 0);
    if (per_cu > 2) per_cu = 2;
    if (per_cu < 1) per_cu = 1;
    if (cus <= 0) cus = 256;
    grid_blocks = cus * per_cu;
    grid_blocks &= ~7;
  }
  Params p{};
  p.x = (const float*)d_in[0]; p.ln1_g = (const float*)d_in[1]; p.w_in = (const float*)d_in[2]; p.mu = (const float*)d_in[3]; p.w0 = (const float*)d_in[4];
  p.w2 = (const float*)d_in[5]; p.a0 = (const float*)d_in[6]; p.a2 = (const float*)d_in[7]; p.g2 = (const float*)d_in[8]; p.k_k = (const float*)d_in[9];
  p.k_a = (const float*)d_in[10]; p.r_k = (const float*)d_in[11]; p.lnx_w = (const float*)d_in[12]; p.lnx_b = (const float*)d_in[13]; p.v0 = (const float*)d_in[14];
  p.v1 = (const float*)d_in[15]; p.v2 = (const float*)d_in[16]; p.q_gain = (const float*)d_in[17]; p.k_gain = (const float*)d_in[18]; p.pool_w = (const float*)d_in[19];
  p.pool_b = (const float*)d_in[20]; p.pool_scale = (const float*)d_in[21]; p.w_out = (const float*)d_in[22]; p.ln2_g = (const float*)d_in[23];
  p.w_up = (const float*)d_in[24]; p.conv_w = (const float*)d_in[25]; p.conv_b = (const float*)d_in[26]; p.w_down = (const float*)d_in[27];
  p.out = (float*)d_out; p.ws = (unsigned char*)d_ws;
  (void)hipMemsetAsync(d_ws, 0, XB_BYTES, stream);
  void* args[] = {&p};
  hipError_t e = hipLaunchCooperativeKernel((const void*)fwd_megakernel, dim3(grid_blocks), dim3(256), args, 0, stream);
  if (e != hipSuccess) fprintf(stderr, "cooperative launch failed: %s (grid %d)\n", hipGetErrorString(e), grid_blocks);
}
```

```cpp
#include <hip/hip_runtime.h>
#include <stdint.h>
#include <cstdio>

typedef unsigned short bf16_t;
typedef short bf16x8 __attribute__((ext_vector_type(8)));
typedef float f32x4 __attribute__((ext_vector_type(4)));
typedef float f32x16 __attribute__((ext_vector_type(16)));
typedef unsigned u32x4 __attribute__((ext_vector_type(4)));
typedef unsigned u32x2 __attribute__((ext_vector_type(2)));

#define TID ((int)threadIdx.x)
__device__ __forceinline__ int otid() { int t = threadIdx.x; asm volatile("" : "+v"(t)); return t; }
constexpr int T_ = 4096, M_ = 32768;
constexpr size_t MiB = 1u << 20;
constexpr size_t OFF_BAR = 0;
constexpr size_t OFF_BONUS = 1 * MiB;
constexpr size_t OFF_SMALLW = 2 * MiB;
constexpr size_t OFF_WB = 3 * MiB;
constexpr size_t OFF_VFIRST = 51 * MiB;
constexpr size_t OFF_HBUF = 75 * MiB;
constexpr size_t OFF_G = 139 * MiB;
constexpr size_t OFF_SW = 163 * MiB;
constexpr size_t OFF_SR = 211 * MiB;
constexpr size_t OFF_SK = 235 * MiB;
constexpr size_t OFF_SV = 259 * MiB;
constexpr size_t OFF_SA = 283 * MiB;
constexpr size_t OFF_SB = 307 * MiB;
constexpr size_t OFF_PROJR = 331 * MiB;
constexpr size_t OFF_SBQ = 419 * MiB;
constexpr size_t OFF_SBK = 443 * MiB;
constexpr size_t OFF_SBVT = 467 * MiB;
constexpr size_t OFF_POOL = 491 * MiB;
constexpr size_t OFF_ACT = 163 * MiB;
constexpr size_t WB_LAYER = 12582912;
constexpr size_t WB_IN = 0, WB_OUT = 2883584, WB_UP = 3932160, WB_DOWN = 9699328;
constexpr size_t SW_LAYER = 139264;
constexpr size_t SW_W2 = 0, SW_A2 = 24576, SW_G2 = 49152, SW_POOL = 98304, SW_V1 = 114688, SW_V2 = 126976;

struct Params {
  const float* x; const float* ln1_g; const float* w_in; const float* mu; const float* w0; const float* w2; const float* a0; const float* a2; const float* g2;
  const float* k_k; const float* k_a; const float* r_k; const float* lnx_w; const float* lnx_b; const float* v0; const float* v1; const float* v2;
  const float* q_gain; const float* k_gain; const float* pool_w; const float* pool_b; const float* pool_scale; const float* w_out; const float* ln2_g;
  const float* w_up; const float* conv_w; const float* conv_b; const float* w_down;
  float* out; unsigned char* ws;
};

typedef __bf16 bf16x2_t __attribute__((ext_vector_type(2)));
typedef float f32x2_t __attribute__((ext_vector_type(2)));
__device__ __forceinline__ unsigned pk_bf16(float lo, float hi) { f32x2_t f = {lo, hi}; bf16x2_t b = __builtin_convertvector(f, bf16x2_t); return *reinterpret_cast<unsigned*>(&b); }
__device__ __forceinline__ float bf_lo(unsigned u) { return __uint_as_float(u << 16); }
__device__ __forceinline__ float bf_hi(unsigned u) { return __uint_as_float(u & 0xffff0000u); }
__device__ __forceinline__ bf16_t f2bf(float f) { return (bf16_t)(pk_bf16(f, 0.f) & 0xffffu); }
__device__ __forceinline__ bf16x8 pack8(const float* f) { u32x4 w = {pk_bf16(f[0], f[1]), pk_bf16(f[2], f[3]), pk_bf16(f[4], f[5]), pk_bf16(f[6], f[7])}; return *reinterpret_cast<bf16x8*>(&w); }
__device__ __forceinline__ void unpack8(u32x4 u, float* f) { f[0] = bf_lo(u.x); f[1] = bf_hi(u.x); f[2] = bf_lo(u.y); f[3] = bf_hi(u.y); f[4] = bf_lo(u.z); f[5] = bf_hi(u.z); f[6] = bf_lo(u.w); f[7] = bf_hi(u.w); }
__device__ __forceinline__ void unpack4(u32x2 u, float* f) { f[0] = bf_lo(u.x); f[1] = bf_hi(u.x); f[2] = bf_lo(u.y); f[3] = bf_hi(u.y); }
__device__ __forceinline__ u32x2 pack4(float a, float b, float c, float d) { u32x2 r = {pk_bf16(a, b), pk_bf16(c, d)}; return r; }
__device__ __forceinline__ float sigmoidf_(float x) { return __builtin_amdgcn_rcpf(1.f + __expf(-x)); }
__device__ __forceinline__ float softplusf_(float x) { return fmaxf(x, 0.f) + 0.69314718f * __builtin_amdgcn_logf(1.f + __expf(-fabsf(x))); }
__device__ __forceinline__ float tanhf_(float x) { float e = __expf(2.f * x); return 1.f - 2.f * __builtin_amdgcn_rcpf(e + 1.f); }
#define MFMA16(a, b, c) __builtin_amdgcn_mfma_f32_16x16x32_bf16((a), (b), (c), 0, 0, 0)
#define MFMA32(a, b, c) __builtin_amdgcn_mfma_f32_32x32x16_bf16((a), (b), (c), 0, 0, 0)

template <int CTRL> __device__ __forceinline__ float dppf(float x) { return __int_as_float(__builtin_amdgcn_update_dpp(0, __float_as_int(x), CTRL, 0xf, 0xf, true)); }
__device__ __forceinline__ float rowsum16(float x) {
  x += dppf<0xB1>(x);
  x += dppf<0x4E>(x);
  x += dppf<0x141>(x);
  x += dppf<0x140>(x);
  return x;
}
__device__ __forceinline__ float wavesum(float x) {
#pragma unroll
  for (int o = 32; o >= 1; o >>= 1) x += __shfl_xor(x, o);
  return x;
}

#define XB_XCNT(j) (64 * (1 + (j)))
#define XB_XSUB(j) (64 * (17 + (j)))
#define XB_XGEN(j) (64 * (33 + (j)))
#define XB_TOP (64 * 49)
#define XB_TOPGEN (64 * 50)
#define XB_BYTES (64 * 51 * 4)
__device__ __forceinline__ unsigned xb_ld(unsigned* p) { return __hip_atomic_load(p, __ATOMIC_RELAXED, __HIP_MEMORY_SCOPE_AGENT); }
__device__ __forceinline__ unsigned xb_add(unsigned* p, unsigned v) { return __hip_atomic_fetch_add(p, v, __ATOMIC_RELAXED, __HIP_MEMORY_SCOPE_AGENT); }
struct GridBar { unsigned* bar; unsigned x, nloc, nx; };
__device__ __forceinline__ void grid_barrier(GridBar& gb) {
  asm volatile("s_waitcnt vmcnt(0) lgkmcnt(0)" ::: "memory");
  __syncthreads();
  if (threadIdx.x == 0) {
    unsigned* bar = gb.bar;
    if (gb.nloc == 0u) {
      const unsigned G = gridDim.x;
      unsigned sum, cnt, mine;
      for (;;) {
        sum = 0u; cnt = 0u; mine = 0u;
#pragma unroll
        for (unsigned j = 0; j < 16; ++j) { const unsigned cc = xb_ld(&bar[XB_XCNT(j)]); sum += cc; cnt += (cc > 0u) ? 1u : 0u; mine = (j == gb.x) ? cc : mine; }
        if (sum == G) break;
        __builtin_amdgcn_s_sleep(1);
      }
      gb.nloc = mine; gb.nx = cnt;
    }
    const unsigned old = xb_add(&bar[XB_XSUB(gb.x)], 1u);
    const unsigned gen = old / gb.nloc;
    if (old + 1u == (gen + 1u) * gb.nloc) {
      __builtin_amdgcn_fence(__ATOMIC_RELEASE, "agent");
      asm volatile("s_waitcnt vmcnt(0)" ::: "memory");
      const unsigned og = xb_add(&bar[XB_TOP], 1u);
      const unsigned tg = og / gb.nx;
      if (og + 1u == (tg + 1u) * gb.nx) xb_add(&bar[XB_TOPGEN], 1u);
      else { while (xb_ld(&bar[XB_TOPGEN]) == tg) __builtin_amdgcn_s_sleep(1); }
      __builtin_amdgcn_fence(__ATOMIC_ACQUIRE, "agent");
      xb_add(&bar[XB_XGEN(gb.x)], 1u);
      asm volatile("s_waitcnt vmcnt(0)" ::: "memory");
    } else {
      while (xb_ld(&bar[XB_XGEN(gb.x)]) == gen) __builtin_amdgcn_s_sleep(1);
      __builtin_amdgcn_fence(__ATOMIC_ACQUIRE, "agent");
      asm volatile("s_waitcnt vmcnt(0)" ::: "memory");
    }
  }
  __syncthreads();
}

template <int PERM>
__device__ void transpose_big(const float* __restrict__ src, int K, int N, int Ndst, bf16_t* dst, int vb, int G, unsigned char* smem) {
  float* tile = (float*)smem;
  const int nkt = K >> 6, nnt = Ndst >> 6, ntile = nkt * nnt;
  const int tid_ = otid(); const int tl = tid_ & 63, th = tid_ >> 6;
  for (int tt = vb; tt < ntile; tt += G) {
    const int kt = tt % nkt, nt = tt / nkt;
    const int k0 = kt << 6, n0 = nt << 6;
    int sc;
    if (PERM == 0) sc = n0 + tl; else sc = (tl < 32) ? (nt * 32 + tl) : (2816 + nt * 32 + tl - 32);
#pragma unroll
    for (int i = 0; i < 16; ++i) { const int kk = i * 4 + th; tile[kk * 65 + tl] = src[(size_t)(k0 + kk) * N + sc]; }
    __syncthreads();
#pragma unroll
    for (int i = 0; i < 16; ++i) { const int nn = i * 4 + th; dst[(size_t)(n0 + nn) * K + k0 + tl] = f2bf(tile[tl * 65 + nn]); }
    __syncthreads();
  }
}
__device__ void transpose_small(const float* __restrict__ src, int K, int N, bf16_t* dst, int gt, int nt) {
  const int tot = K * N;
  for (int i = gt; i < tot; i += nt) { const int n = i / K, k = i - n * K; dst[i] = f2bf(src[(size_t)k * N + n]); }
}

__device__ void prep_phase(const Params& p, int part, int vb, int G, int gt, int nt, unsigned char* smem) {
  bf16_t* wb = (bf16_t*)(p.ws + OFF_WB);
  bf16_t* sw = (bf16_t*)(p.ws + OFF_SMALLW);
  for (int l = 0; l < 2; ++l) {
    bf16_t* w = wb + (size_t)l * WB_LAYER;
    const bool first = (l == 0);
    if ((part == 0) == first) {
      transpose_big<0>(p.w_in + (size_t)l * 1024 * 2816, 1024, 2816, 2816, w + WB_IN, vb, G, smem);
      bf16_t* s = sw + (size_t)l * SW_LAYER;
      transpose_small(p.w2 + (size_t)l * 64 * 384, 64, 384, s + SW_W2, gt, nt);
      transpose_small(p.a2 + (size_t)l * 64 * 384, 64, 384, s + SW_A2, gt, nt);
      transpose_small(p.g2 + (size_t)l * 128 * 384, 128, 384, s + SW_G2, gt, nt);
      for (int g = 0; g < 4; ++g) transpose_small(p.pool_w + (size_t)(l * 4 + g) * 4096, 64, 64, s + SW_POOL + g * 4096, gt, nt);
      if (l == 1) {
        transpose_small(p.v1, 384, 32, s + SW_V1, gt, nt);
        transpose_small(p.v2, 32, 384, s + SW_V2, gt, nt);
      }
    }
    if (part == 1) {
      transpose_big<0>(p.w_out + (size_t)l * 1024 * 1024, 1024, 1024, 1024, w + WB_OUT, vb, G, smem);
      transpose_big<1>(p.w_up + (size_t)l * 1024 * 5632, 1024, 5632, 5632, w + WB_UP, vb, G, smem);
      transpose_big<0>(p.w_down + (size_t)l * 2816 * 1024, 2816, 1024, 1024, w + WB_DOWN, vb, G, smem);
    }
  }
}

__device__ void norm_phase(const float* x, const float* __restrict__ g, bf16_t* h, int gw, int nw) {
  const int lane = otid() & 63;
  for (int row = gw; row < M_; row += nw) {
    const float4* xr = (const float4*)(x + (size_t)row * 1024);
    float4 v[4]; float ss = 0.f;
#pragma unroll
    for (int i = 0; i < 4; ++i) { v[i] = xr[lane + 64 * i]; ss += v[i].x * v[i].x + v[i].y * v[i].y + v[i].z * v[i].z + v[i].w * v[i].w; }
    ss = wavesum(ss);
    const float rs = rsqrtf(ss * (1.f / 1024.f) + 1e-6f);
#pragma unroll
    for (int i = 0; i < 4; ++i) {
      const float4 gv = ((const float4*)g)[lane + 64 * i];
      *(u32x2*)(h + (size_t)row * 1024 + (lane + 64 * i) * 4) = pack4(v[i].x * rs * gv.x, v[i].y * rs * gv.y, v[i].z * rs * gv.z, v[i].w * rs * gv.w);
    }
  }
}

#define LAS __attribute__((address_space(3)))
__device__ __forceinline__ void stage_rc(int b, int& R, int& C) {
  R = b >> 7; C = (((b >> 4) & 7) ^ (R & 7)) * 8;
}
#define GSTAGE(A_, W_, ao_, wo_, buf, kt) do { const int _wb = __builtin_amdgcn_readfirstlane(tid >> 6) * 1024; _Pragma("unroll") for (int _i = 0; _i < 4; ++_i) { \
    __builtin_amdgcn_global_load_lds((const unsigned*)((A_) + (ao_)[_i] + (kt) * 64), (LAS unsigned*)((LAS unsigned char*)smem + (buf) * 32768 + _wb + _i * 4096), 16, 0, 0); \
    __builtin_amdgcn_global_load_lds((const unsigned*)((W_) + (wo_)[_i] + (kt) * 64), (LAS unsigned*)((LAS unsigned char*)smem + (buf) * 32768 + 16384 + _wb + _i * 4096), 16, 0, 0); } } while (0)
__device__ __forceinline__ void gemm_mainloop(const bf16_t* A, const bf16_t* W, const unsigned (&ao)[4], const unsigned (&wo)[4], int nk, unsigned char* smem, f32x4 (&acc)[4][4]) {
  const int tid = otid(), lane = tid & 63, wave = tid >> 6, wr = wave >> 1, wc = wave & 1, fr = lane & 15, fq = lane >> 4;
  const int foff0 = fr * 128 + ((fq ^ (fr & 7)) << 4), foff1 = fr * 128 + (((4 + fq) ^ (fr & 7)) << 4);
  const int aoff = (wr * 64) * 128, boff = 16384 + (wc * 64) * 128;
  asm volatile("s_waitcnt vmcnt(0)" ::: "memory");
  __syncthreads();
  for (int kt = 0; kt < nk; ++kt) {
    const int cb = kt & 1;
    unsigned char* cur = smem + cb * 32768;
    bf16x8 af[2][4], wf[2][4];
#pragma unroll
    for (int ks = 0; ks < 2; ++ks) {
#pragma unroll
      for (int mt = 0; mt < 4; ++mt) af[ks][mt] = *(const bf16x8*)(cur + aoff + mt * 2048 + (ks ? foff1 : foff0));
#pragma unroll
      for (int nt = 0; nt < 4; ++nt) wf[ks][nt] = *(const bf16x8*)(cur + boff + nt * 2048 + (ks ? foff1 : foff0));
    }
    __builtin_amdgcn_sched_barrier(0);
    if (kt + 1 < nk) GSTAGE(A, W, ao, wo, cb ^ 1, kt + 1);
#pragma unroll
    for (int ks = 0; ks < 2; ++ks) {
#pragma unroll
      for (int nt = 0; nt < 4; ++nt)
#pragma unroll
        for (int mt = 0; mt < 4; ++mt) acc[nt][mt] = MFMA16(wf[ks][nt], af[ks][mt], acc[nt][mt]);
    }
    __builtin_amdgcn_sched_barrier(0);
    asm volatile("s_waitcnt vmcnt(0)" ::: "memory");
    __syncthreads();
  }
}

template <int MODE>
__device__ void gemm_phase(const Params& p, int l, int vb, int G, unsigned char* smem) {
  const int tid = otid(), lane = tid & 63, wave = tid >> 6, wr = wave >> 1, wc = wave & 1, fr = lane & 15, fq = lane >> 4;
  const bf16_t* wbl = (const bf16_t*)(p.ws + OFF_WB) + (size_t)l * WB_LAYER;
  const bf16_t* A; const bf16_t* W; int K, nN, nM, lda;
  if (MODE == 0) { A = (const bf16_t*)(p.ws + OFF_HBUF); W = wbl + WB_IN; K = 1024; nN = 22; nM = 256; lda = 1024; }
  if (MODE == 1) { A = (const bf16_t*)(p.ws + OFF_HBUF); W = wbl + WB_OUT; K = 1024; nN = 8; nM = 256; lda = 1024; }
  if (MODE == 2) { A = (const bf16_t*)(p.ws + OFF_HBUF); W = wbl + WB_UP; K = 1024; nN = 44; nM = 264; lda = 1024; }
  if (MODE == 3) { A = (const bf16_t*)(p.ws + OFF_ACT); W = wbl + WB_DOWN; K = 2816; nN = 8; nM = 256; lda = 2816; }
  const int ntile = nM * nN, nk = K >> 6;
  auto tile_pmn = [&](int tile, int& pm_, int& pn_) { const int grp = tile / (8 * nN), within = tile - grp * (8 * nN); pm_ = grp * 8 + (within & 7); pn_ = within >> 3; };
  auto tile_offs = [&](int pm_, int pn_, unsigned (&ao_)[4], unsigned (&wo_)[4]) {
    int tb_ = 0, ti_ = 0;
    if (MODE == 2) { tb_ = pm_ / 33; ti_ = pm_ - tb_ * 33; }
#pragma unroll
    for (int i = 0; i < 4; ++i) {
      int r, cc; stage_rc(tid * 16 + i * 4096, r, cc);
      unsigned grow;
      if (MODE == 2) { int t = 126 * ti_ - 2 + r; t = t < 0 ? 0 : (t > 4095 ? 4095 : t); grow = (unsigned)(tb_ * 4096 + t); }
      else grow = (unsigned)(pm_ * 128 + r);
      ao_[i] = grow * (unsigned)lda + (unsigned)cc;
      wo_[i] = (unsigned)(pn_ * 128 + r) * (unsigned)K + (unsigned)cc;
    }
  };
  unsigned ao[4], wo[4];
  int pm = 0, pn = 0;
  if (vb < ntile) { tile_pmn(vb, pm, pn); tile_offs(pm, pn, ao, wo); GSTAGE(A, W, ao, wo, 0, 0); }
  for (int tile = vb; tile < ntile; tile += G) {
    const int n0 = pn * 128;
    int tb = 0, ti = 0;
    if (MODE == 2) { tb = pm / 33; ti = pm - tb * 33; }
    f32x4 acc[4][4];
#pragma unroll
    for (int a = 0; a < 4; ++a)
#pragma unroll
      for (int b = 0; b < 4; ++b) acc[a][b] = (f32x4){0.f, 0.f, 0.f, 0.f};
    gemm_mainloop(A, W, ao, wo, nk, smem, acc);
    const int cpm = pm; (void)cpm;
    int npm = 0, npn = 0;
    const bool has_next = (tile + G) < ntile;
    if (has_next) { tile_pmn(tile + G, npm, npn); tile_offs(npm, npn, ao, wo); }
    if (MODE != 2) { if (has_next) GSTAGE(A, W, ao, wo, 0, 0); }

    if (MODE == 0) {
      const int cg = (n0 + wc * 64) >> 6;
#pragma unroll
      for (int mt = 0; mt < 4; ++mt) {
        const int tok = pm * 128 + wr * 64 + mt * 16 + fr;
        const int b = tok >> 12, t = tok & 4095;
        if (cg < 22) {
          bf16_t* d = (bf16_t*)(p.ws + OFF_PROJR) + (size_t)tok * 1408 + cg * 64 + fq * 4;
#pragma unroll
          for (int nt = 0; nt < 4; ++nt) *(u32x2*)(d + nt * 16) = pack4(acc[nt][mt][0], acc[nt][mt][1], acc[nt][mt][2], acc[nt][mt][3]);
        } else if (cg < 34) {
          const bool isq = cg < 28; const int head = isq ? cg - 22 : cg - 28;
          const float* gain = (isq ? p.q_gain : p.k_gain) + l * 64;
          float ss = 0.f;
#pragma unroll
          for (int nt = 0; nt < 4; ++nt)
#pragma unroll
            for (int j = 0; j < 4; ++j) ss += acc[nt][mt][j] * acc[nt][mt][j];
          ss += __shfl_xor(ss, 16); ss += __shfl_xor(ss, 32);
          const float rs = rsqrtf(ss * (1.f / 64.f) + 1e-6f) * (isq ? 0.125f : 1.f);
          bf16_t* d = (bf16_t*)(p.ws + (isq ? OFF_SBQ : OFF_SBK)) + ((size_t)(b * 6 + head) * 4096 + t) * 64 + fq * 4;
#pragma unroll
          for (int nt = 0; nt < 4; ++nt) {
            const float4 gv = *(const float4*)(gain + nt * 16 + fq * 4);
            *(u32x2*)(d + nt * 16) = pack4(acc[nt][mt][0] * rs * gv.x, acc[nt][mt][1] * rs * gv.y, acc[nt][mt][2] * rs * gv.z, acc[nt][mt][3] * rs * gv.w);
          }
        } else if (cg < 40) {
          const int head = cg - 34;
          bf16_t* d = (bf16_t*)(p.ws + OFF_SBVT) + ((size_t)(b * 6 + head) * 64 + fq * 4) * 4096 + t;
#pragma unroll
          for (int nt = 0; nt < 4; ++nt)
#pragma unroll
            for (int j = 0; j < 4; ++j) d[(size_t)(nt * 16 + j) * 4096] = f2bf(acc[nt][mt][j]);
        } else {
          bf16_t* d = (bf16_t*)(p.ws + OFF_POOL) + (size_t)tok * 256 + (cg - 40) * 64 + fq * 4;
#pragma unroll
          for (int nt = 0; nt < 4; ++nt) *(u32x2*)(d + nt * 16) = pack4(acc[nt][mt][0], acc[nt][mt][1], acc[nt][mt][2], acc[nt][mt][3]);
        }
      }
    }
    if (MODE == 1 || MODE == 3) {
      const float* resid = (MODE == 1 && l == 0) ? p.x : p.out;
#pragma unroll
      for (int mh = 0; mh < 2; ++mh) {
        float4 rv[2][4];
#pragma unroll
        for (int m2 = 0; m2 < 2; ++m2) {
          const size_t tok = (size_t)pm * 128 + wr * 64 + (mh * 2 + m2) * 16 + fr;
#pragma unroll
          for (int nt = 0; nt < 4; ++nt) rv[m2][nt] = *(const float4*)(resid + tok * 1024 + n0 + wc * 64 + nt * 16 + fq * 4);
        }
#pragma unroll
        for (int m2 = 0; m2 < 2; ++m2) {
          const int mt = mh * 2 + m2;
          const size_t tok = (size_t)pm * 128 + wr * 64 + mt * 16 + fr;
#pragma unroll
          for (int nt = 0; nt < 4; ++nt) {
            float4 ov; ov.x = rv[m2][nt].x + acc[nt][mt][0]; ov.y = rv[m2][nt].y + acc[nt][mt][1]; ov.z = rv[m2][nt].z + acc[nt][mt][2]; ov.w = rv[m2][nt].w + acc[nt][mt][3];
            *(float4*)(p.out + tok * 1024 + n0 + wc * 64 + nt * 16 + fq * 4) = ov;
          }
        }
      }
    }
    if (MODE == 2) {
      float* halo = (float*)(smem + 32768);
      if (ti == 0 && wr == 0 && fr < 2) {
#pragma unroll
        for (int nt = 0; nt < 4; ++nt) acc[nt][0] = (f32x4){0.f, 0.f, 0.f, 0.f};
      }
      if (wr == 0 && fr >= 14) {
#pragma unroll
        for (int nt = 0; nt < 4; ++nt) *(f32x4*)(halo + (wc * 2 + (fr - 14)) * 64 + nt * 16 + fq * 4) = acc[nt][3];
      }
      __syncthreads();
      f32x4 xm1[4];
#pragma unroll
      for (int nt = 0; nt < 4; ++nt) {
        xm1[nt] = (f32x4){0.f, 0.f, 0.f, 0.f};
        if (wr == 1 && fr >= 14) xm1[nt] = *(const f32x4*)(halo + (wc * 2 + (fr - 14)) * 64 + nt * 16 + fq * 4);
      }
      __syncthreads();
      if (has_next) GSTAGE(A, W, ao, wo, 0, 0);
      const int Gc = (n0 + wc * 64) >> 6;
      const float* cw = p.conv_w + (size_t)l * 3 * 5632;
      const float* cb = p.conv_b + (size_t)l * 5632;
      bf16_t* actp = (bf16_t*)(p.ws + OFF_ACT);
#pragma unroll
      for (int nt = 0; nt < 2; ++nt) {
        const int ch = 32 * Gc + nt * 16 + fq * 4;
        const float4 cbg = *(const float4*)(cb + ch), cbv = *(const float4*)(cb + 2816 + ch);
        float4 cwg[3], cwv[3];
#pragma unroll
        for (int i = 0; i < 3; ++i) { cwg[i] = *(const float4*)(cw + i * 5632 + ch); cwv[i] = *(const float4*)(cw + i * 5632 + 2816 + ch); }
#pragma unroll
        for (int mt = 0; mt < 4; ++mt) {
          const int rt = wr * 64 + mt * 16 + fr;
          const int t = 126 * ti - 2 + rt;
          const bool valid = (rt >= 2) && (t < 4096);
          float o[4];
#pragma unroll
          for (int j = 0; j < 4; ++j) {
            float cvv[2];
#pragma unroll
            for (int gvi = 0; gvi < 2; ++gvi) {
              const int n2 = nt + 2 * gvi;
              const float x0 = acc[n2][mt][j];
              const float xp = (mt == 0) ? xm1[n2][j] : acc[n2][mt == 0 ? 0 : mt - 1][j];
              const float p1 = dppf<0x121>((fr == 15) ? xp : x0);
              const float p2 = dppf<0x122>((fr >= 14) ? xp : x0);
              const float4* wv = gvi ? cwv : cwg;
              const float bias = gvi ? ((const float*)&cbv)[j] : ((const float*)&cbg)[j];
              cvv[gvi] = bias + ((const float*)&wv[0])[j] * p2 + ((const float*)&wv[1])[j] * p1 + ((const float*)&wv[2])[j] * x0;
            }
            o[j] = cvv[0] * sigmoidf_(cvv[0]) * cvv[1];
          }
          if (valid) *(u32x2*)(actp + ((size_t)tb * 4096 + t) * 2816 + ch) = pack4(o[0], o[1], o[2], o[3]);
        }
      }
    }
    pm = npm; pn = npn;
  }
#undef GSTAGE
}

__device__ void rwkv_prep_task(const Params& p, int l, int tok0, unsigned char* smem) {
  const int lane = otid() & 63, fr = lane & 15, fq = lane >> 4;
  const int tok = tok0 + fr, t = tok & 4095;
  const bool hasprev = t > 0;
  const bf16_t* cur = (const bf16_t*)(p.ws + OFF_PROJR) + (size_t)tok * 1408;
  const bf16_t* prv = cur - (hasprev ? 1408 : 0);
  const float* mu = p.mu + l * 1408;
  const bf16_t* sw = (const bf16_t*)(p.ws + OFF_SMALLW) + (size_t)l * SW_LAYER;
  auto shift8 = [&](int c, float* o) {
    u32x4 uc = *(const u32x4*)(cur + c); u32x4 up = *(const u32x4*)(prv + c);
    float fc[8], fp[8]; unpack8(uc, fc); unpack8(up, fp);
    const float4 m0 = *(const float4*)(mu + c), m1 = *(const float4*)(mu + c + 4);
    const float m[8] = {m0.x, m0.y, m0.z, m0.w, m1.x, m1.y, m1.z, m1.w};
#pragma unroll
    for (int i = 0; i < 8; ++i) { const float pv = hasprev ? fp[i] : 0.f; o[i] = fc[i] + (pv - fc[i]) * m[i]; }
  };
  auto shift4 = [&](int c, float* o) {
    u32x2 uc = *(const u32x2*)(cur + c); u32x2 up = *(const u32x2*)(prv + c);
    float fc[4], fp[4]; unpack4(uc, fc); unpack4(up, fp);
    const float4 m0 = *(const float4*)(mu + c);
    const float m[4] = {m0.x, m0.y, m0.z, m0.w};
#pragma unroll
    for (int i = 0; i < 4; ++i) { const float pv = hasprev ? fp[i] : 0.f; o[i] = fc[i] + (pv - fc[i]) * m[i]; }
  };
  bf16x8 Bw[2], Ba[2], Bg[4], Bu;
  {
    float o[8];
#pragma unroll
    for (int ks = 0; ks < 2; ++ks) {
      shift8(1152 + ks * 32 + fq * 8, o);
#pragma unroll
      for (int i = 0; i < 8; ++i) o[i] = tanhf_(o[i]);
      Bw[ks] = pack8(o);
      shift8(1216 + ks * 32 + fq * 8, o);
      Ba[ks] = pack8(o);
    }
#pragma unroll
    for (int ks = 0; ks < 4; ++ks) {
      shift8(1280 + ks * 32 + fq * 8, o);
#pragma unroll
      for (int i = 0; i < 8; ++i) o[i] = sigmoidf_(o[i]);
      Bg[ks] = pack8(o);
    }
  }
  if (l == 1) {
    f32x4 u0 = {0.f, 0.f, 0.f, 0.f}, u1 = {0.f, 0.f, 0.f, 0.f};
    const bf16_t* v1t = sw + SW_V1;
#pragma unroll 2
    for (int ks = 0; ks < 12; ++ks) {
      float o[8]; shift8(768 + ks * 32 + fq * 8, o);
      const bf16x8 bv = pack8(o);
      const bf16x8 a0 = *(const bf16x8*)(v1t + (size_t)fr * 384 + ks * 32 + fq * 8);
      const bf16x8 a1 = *(const bf16x8*)(v1t + (size_t)(16 + fr) * 384 + ks * 32 + fq * 8);
      u0 = MFMA16(a0, bv, u0); u1 = MFMA16(a1, bv, u1);
    }
    const float uu[8] = {u0[0], u0[1], u0[2], u0[3], u1[0], u1[1], u1[2], u1[3]};
    Bu = pack8(uu);
  }
  const float* w0 = p.w0 + l * 384; const float* a0p = p.a0 + l * 384; const float* kkp = p.k_k + l * 384; const float* kap = p.k_a + l * 384;
  const float* rkp = p.r_k + l * 384; const float* v0p = p.v0;
  bf16_t* SR = (bf16_t*)(p.ws + OFF_SR); bf16_t* SK = (bf16_t*)(p.ws + OFF_SK); bf16_t* SV = (bf16_t*)(p.ws + OFF_SV);
  bf16_t* SA = (bf16_t*)(p.ws + OFF_SA); bf16_t* SBp = (bf16_t*)(p.ws + OFF_SB); bf16_t* Gp = (bf16_t*)(p.ws + OFF_G);
  bf16_t* VF = (bf16_t*)(p.ws + OFF_VFIRST); bf16_t* SWp = (bf16_t*)(p.ws + OFF_SW); float* bonus = (float*)(p.ws + OFF_BONUS);
  const int stid = otid();
#pragma unroll 1
  for (int h = 0; h < 6; ++h) {
    __syncthreads();
    {
      u32x4 t0, t1, t2, t3;
      { const int q0 = stid, q1 = stid + 256;
        t0 = *(const u32x4*)(sw + SW_W2 + (size_t)(h * 64 + (q0 >> 3)) * 64 + (q0 & 7) * 8); t1 = *(const u32x4*)(sw + SW_W2 + (size_t)(h * 64 + (q1 >> 3)) * 64 + (q1 & 7) * 8);
        t2 = *(const u32x4*)(sw + SW_A2 + (size_t)(h * 64 + (q0 >> 3)) * 64 + (q0 & 7) * 8); t3 = *(const u32x4*)(sw + SW_A2 + (size_t)(h * 64 + (q1 >> 3)) * 64 + (q1 & 7) * 8);
        *(u32x4*)(smem + (q0 >> 3) * 144 + (q0 & 7) * 16) = t0; *(u32x4*)(smem + (q1 >> 3) * 144 + (q1 & 7) * 16) = t1;
        *(u32x4*)(smem + 9216 + (q0 >> 3) * 144 + (q0 & 7) * 16) = t2; *(u32x4*)(smem + 9216 + (q1 >> 3) * 144 + (q1 & 7) * 16) = t3; }
      __builtin_amdgcn_sched_barrier(0);
      { const int q0 = stid, q1 = stid + 256, q2 = stid + 512, q3 = stid + 768;
        t0 = *(const u32x4*)(sw + SW_G2 + (size_t)(h * 64 + (q0 >> 4)) * 128 + (q0 & 15) * 8); t1 = *(const u32x4*)(sw + SW_G2 + (size_t)(h * 64 + (q1 >> 4)) * 128 + (q1 & 15) * 8);
        t2 = *(const u32x4*)(sw + SW_G2 + (size_t)(h * 64 + (q2 >> 4)) * 128 + (q2 & 15) * 8); t3 = *(const u32x4*)(sw + SW_G2 + (size_t)(h * 64 + (q3 >> 4)) * 128 + (q3 & 15) * 8);
        *(u32x4*)(smem + 18432 + (q0 >> 4) * 272 + (q0 & 15) * 16) = t0; *(u32x4*)(smem + 18432 + (q1 >> 4) * 272 + (q1 & 15) * 16) = t1;
        *(u32x4*)(smem + 18432 + (q2 >> 4) * 272 + (q2 & 15) * 16) = t2; *(u32x4*)(smem + 18432 + (q3 >> 4) * 272 + (q3 & 15) * 16) = t3; }
    }
    __syncthreads();
    const int cb = h * 64 + 8 * fq;
    __builtin_amdgcn_sched_barrier(0);
    float ss = 0.f;
    {
      float k16[16];
      shift8(384 + cb, k16); shift8(384 + cb + 32, k16 + 8);
#pragma unroll
      for (int q = 0; q < 4; ++q) {
        const float4 kkv = *(const float4*)(kkp + cb + 32 * (q >> 1) + 4 * (q & 1));
        const float x0 = k16[4 * q] * kkv.x, x1 = k16[4 * q + 1] * kkv.y, x2 = k16[4 * q + 2] * kkv.z, x3 = k16[4 * q + 3] * kkv.w;
        ss += x0 * x0 + x1 * x1 + x2 * x2 + x3 * x3;
      }
    }
    ss += __shfl_xor(ss, 16); ss += __shfl_xor(ss, 32);
    const float inv = 1.f / fmaxf(sqrtf(ss), 1e-12f);
    float bsum = 0.f;
#pragma unroll 1
    for (int half = 0; half < 2; ++half) {
      f32x4 lw[2], la[2], lg[2], lv[2];
#pragma unroll
      for (int n2 = 0; n2 < 2; ++n2) {
        const int nt = 2 * half + n2;
        lw[n2] = (f32x4){0.f, 0.f, 0.f, 0.f}; la[n2] = lw[n2]; lg[n2] = lw[n2]; lv[n2] = lw[n2];
        const int rloc = 32 * half + 8 * (fr >> 2) + 4 * n2 + (fr & 3);
        const int crow = h * 64 + rloc;
#pragma unroll
        for (int ks = 0; ks < 2; ++ks) {
          lw[n2] = MFMA16(*(const bf16x8*)(smem + rloc * 144 + (ks * 4 + fq) * 16), Bw[ks], lw[n2]);
          la[n2] = MFMA16(*(const bf16x8*)(smem + 9216 + rloc * 144 + (ks * 4 + fq) * 16), Ba[ks], la[n2]);
        }
#pragma unroll
        for (int ks = 0; ks < 4; ++ks) lg[n2] = MFMA16(*(const bf16x8*)(smem + 18432 + rloc * 272 + (ks * 4 + fq) * 16), Bg[ks], lg[n2]);
        if (l == 1) {
          const u32x2 lo = *(const u32x2*)(sw + SW_V2 + (size_t)crow * 32 + 4 * fq);
          const u32x2 hi = *(const u32x2*)(sw + SW_V2 + (size_t)crow * 32 + 16 + 4 * fq);
          u32x4 av = {lo.x, lo.y, hi.x, hi.y};
          lv[n2] = MFMA16(*reinterpret_cast<bf16x8*>(&av), Bu, lv[n2]);
        }
      }
      const int c8 = cb + 32 * half;
      const size_t o = (size_t)tok * 384 + c8;
      float r8[8], v8[8], k8[8], w0a[8], a0a[8], kaa[8], rka[8], kka[8];
      shift8(c8, r8); shift8(768 + c8, v8); shift8(384 + c8, k8);
#pragma unroll
      for (int q = 0; q < 2; ++q) {
        const float4 t0 = *(const float4*)(w0 + c8 + 4 * q), t1 = *(const float4*)(a0p + c8 + 4 * q), t2 = *(const float4*)(kap + c8 + 4 * q), t3 = *(const float4*)(rkp + c8 + 4 * q);
        const float4 t4 = *(const float4*)(kkp + c8 + 4 * q);
        kka[4 * q] = t4.x; kka[4 * q + 1] = t4.y; kka[4 * q + 2] = t4.z; kka[4 * q + 3] = t4.w;
        w0a[4 * q] = t0.x; w0a[4 * q + 1] = t0.y; w0a[4 * q + 2] = t0.z; w0a[4 * q + 3] = t0.w;
        a0a[4 * q] = t1.x; a0a[4 * q + 1] = t1.y; a0a[4 * q + 2] = t1.z; a0a[4 * q + 3] = t1.w;
        kaa[4 * q] = t2.x; kaa[4 * q + 1] = t2.y; kaa[4 * q + 2] = t2.z; kaa[4 * q + 3] = t2.w;
        rka[4 * q] = t3.x; rka[4 * q + 1] = t3.y; rka[4 * q + 2] = t3.z; rka[4 * q + 3] = t3.w;
      }
      if (l == 1) {
        float vf[8], v0a[8]; unpack8(*(const u32x4*)(VF + o), vf);
        const float4 t0 = *(const float4*)(v0p + c8), t1 = *(const float4*)(v0p + c8 + 4);
        v0a[0] = t0.x; v0a[1] = t0.y; v0a[2] = t0.z; v0a[3] = t0.w; v0a[4] = t1.x; v0a[5] = t1.y; v0a[6] = t1.z; v0a[7] = t1.w;
#pragma unroll
        for (int e8 = 0; e8 < 8; ++e8) v8[e8] = v8[e8] + (vf[e8] - v8[e8]) * sigmoidf_(v0a[e8] + lv[e8 >> 2][e8 & 3]);
      } else {
        *(bf16x8*)(VF + o) = pack8(v8);
      }
      float dec[8], kf[8], an[8], bn[8], gg[8];
#pragma unroll
      for (int e8 = 0; e8 < 8; ++e8) {
        const int nt = e8 >> 2, j = e8 & 3, e = 8 * half + e8;
        dec[e8] = 1.f - __expf(-0.60653066f * sigmoidf_(w0a[e8] + lw[nt][j]));
        const float sa = sigmoidf_(a0a[e8] + la[nt][j]);
        const float kn = k8[e8] * kka[e8] * inv;
        an[e8] = -kn; bn[e8] = kn * sa;
        kf[e8] = k8[e8] * (1.f + (sa - 1.f) * kaa[e8]);
        bsum += r8[e8] * kf[e8] * rka[e8];
        gg[e8] = lg[nt][j];
      }
      *(bf16x8*)(SWp + o) = pack8(dec);
      *(bf16x8*)(SR + o) = pack8(r8);
      *(bf16x8*)(SK + o) = pack8(kf);
      *(bf16x8*)(SV + o) = pack8(v8);
      *(bf16x8*)(Gp + o) = pack8(gg);
      *(bf16x8*)(SA + o) = pack8(an);
      *(bf16x8*)(SBp + o) = pack8(bn);
    }
    bsum += __shfl_xor(bsum, 16); bsum += __shfl_xor(bsum, 32);
    if (fq == 0) bonus[(size_t)tok * 6 + h] = bsum;
  }
}

__device__ void pool_task(const Params& p, int l, int tok0) {
  const int lane = otid() & 63, fr = lane & 15, fq = lane >> 4;
  const int tok = tok0 + fr, t = tok & 4095;
  const bf16_t* u = (const bf16_t*)(p.ws + OFF_POOL) + (size_t)tok * 256;
  const bf16_t* pt = (const bf16_t*)(p.ws + OFF_SMALLW) + (size_t)l * SW_LAYER + SW_POOL;
  bf16_t* mix = (bf16_t*)(p.ws + OFF_HBUF);
#pragma unroll
  for (int g = 0; g < 4; ++g) {
    const int w = 2 << g;
    const int cnt = (t + 1) < w ? (t + 1) : w;
    const float icnt = 1.f / (float)cnt;
    bf16x8 B[2];
#pragma unroll
    for (int ks = 0; ks < 2; ++ks) {
      const int c = g * 64 + ks * 32 + fq * 8;
      float s[8], f[8], u0[8];
      unpack8(*(const u32x4*)(u + c), u0);
#pragma unroll
      for (int i = 0; i < 8; ++i) s[i] = u0[i];
#pragma unroll
      for (int d0 = 1; d0 < w; d0 += 8) {
        u32x4 wr_[8];
#pragma unroll
        for (int q = 0; q < 8; ++q) { const int d = d0 + q; if (d < w) { const int dd = d < cnt ? d : 0; wr_[q] = *(const u32x4*)(u + c - (size_t)dd * 256); } }
#pragma unroll
        for (int q = 0; q < 8; ++q) { const int d = d0 + q; if (d < w) { unpack8(wr_[q], f);
#pragma unroll
          for (int i = 0; i < 8; ++i) s[i] += (d < cnt) ? f[i] : 0.f; } }
      }
#pragma unroll
      for (int i = 0; i < 8; ++i) s[i] = s[i] * icnt - u0[i];
      B[ks] = pack8(s);
    }
    float yo[16];
#pragma unroll
    for (int nt = 0; nt < 4; ++nt) {
      f32x4 acc = {0.f, 0.f, 0.f, 0.f};
      const int drow = 32 * (nt >> 1) + 8 * (fr >> 2) + 4 * (nt & 1) + (fr & 3);
#pragma unroll
      for (int ks = 0; ks < 2; ++ks) acc = MFMA16(*(const bf16x8*)(pt + (size_t)g * 4096 + (size_t)drow * 64 + ks * 32 + fq * 8), B[ks], acc);
      const int d = 32 * (nt >> 1) + 8 * fq + 4 * (nt & 1);
      const float4 bv = *(const float4*)(p.pool_b + (size_t)(l * 4 + g) * 64 + d);
      const float4 sv = *(const float4*)(p.pool_scale + (size_t)l * 256 + g * 64 + d);
      yo[4 * nt] = (acc[0] + bv.x) * sv.x; yo[4 * nt + 1] = (acc[1] + bv.y) * sv.y; yo[4 * nt + 2] = (acc[2] + bv.z) * sv.z; yo[4 * nt + 3] = (acc[3] + bv.w) * sv.w;
    }
    *(bf16x8*)(mix + (size_t)tok * 1024 + 768 + g * 64 + 8 * fq) = pack8(yo);
    *(bf16x8*)(mix + (size_t)tok * 1024 + 768 + g * 64 + 32 + 8 * fq) = pack8(yo + 8);
  }
}

__device__ void scan_block(const Params& p, int sb, unsigned char* smem) {
  const int tid = otid(), lane = tid & 63, wave = tid >> 6, rr = lane >> 4, c = lane & 15;
  const int bh = sb >> 2, rq = sb & 3, b = bh / 6, h = bh - b * 6;
  const int rloc = wave * 4 + rr;
  const int row = rq * 16 + rloc;
  const size_t base = (size_t)b * 4096 * 384 + h * 64;
  const bf16_t* SR = (const bf16_t*)(p.ws + OFF_SR); const bf16_t* SK = (const bf16_t*)(p.ws + OFF_SK); const bf16_t* SV = (const bf16_t*)(p.ws + OFF_SV);
  const bf16_t* SA = (const bf16_t*)(p.ws + OFF_SA); const bf16_t* SBp = (const bf16_t*)(p.ws + OFF_SB); const bf16_t* SWp = (const bf16_t*)(p.ws + OFF_SW);
  float* Y = (float*)(p.ws + OFF_PROJR);
  float* lds = (float*)smem;
  constexpr int STEP = 336, BUF = 16 * STEP;
  const int q0 = tid, q1 = tid + 256;
  const int arr0 = q0 >> 7, st0 = (q0 & 127) >> 3, pt0 = q0 & 7;
  const int arr1 = q1 >> 7, st1 = (q1 & 127) >> 3, pt1 = q1 & 7;
  const bf16_t* src0 = (arr0 == 0 ? SA : SBp) + base + (size_t)st0 * 384 + pt0 * 8;
  const bf16_t* src1 = (arr1 == 2 ? SK : SR) + base + (size_t)st1 * 384 + pt1 * 8;
  const int slot0 = (arr0 == 0 ? 0 : 64), slot1 = (arr1 == 2 ? 192 : 256);
  const int stw = (tid & 127) >> 3, ptw = tid & 7;
  const bf16_t* srcw = SWp + base + (size_t)stw * 384 + ptw * 8;
  const int stv = (tid & 63) >> 2, ptv = tid & 3;
  const bf16_t* srcv = SV + base + (size_t)stv * 384 + rq * 16 + ptv * 4;
  u32x4 g0, g1, gw = {0u, 0u, 0u, 0u}; u32x2 gv = {0u, 0u};
  auto gload = [&](int ch) {
    const size_t o = (size_t)ch * 16 * 384;
    g0 = *(const u32x4*)(src0 + o); g1 = *(const u32x4*)(src1 + o); if (tid < 128) gw = *(const u32x4*)(srcw + o);
    if (tid < 64) gv = *(const u32x2*)(srcv + o);
  };
  auto lwrite = [&](int bufi) {
    float* L = lds + bufi * BUF;
    float f[8];
    unpack8(g0, f);
    *(float4*)(L + st0 * STEP + slot0 + pt0 * 8) = make_float4(f[0], f[1], f[2], f[3]); *(float4*)(L + st0 * STEP + slot0 + pt0 * 8 + 4) = make_float4(f[4], f[5], f[6], f[7]);
    unpack8(g1, f);
    *(float4*)(L + st1 * STEP + slot1 + pt1 * 8) = make_float4(f[0], f[1], f[2], f[3]); *(float4*)(L + st1 * STEP + slot1 + pt1 * 8 + 4) = make_float4(f[4], f[5], f[6], f[7]);
    if (tid < 128) { unpack8(gw, f); *(float4*)(L + stw * STEP + 128 + ptw * 8) = make_float4(1.f - f[0], 1.f - f[1], 1.f - f[2], 1.f - f[3]); *(float4*)(L + stw * STEP + 128 + ptw * 8 + 4) = make_float4(1.f - f[4], 1.f - f[5], 1.f - f[6], 1.f - f[7]); }
    if (tid < 64) { float v4[4]; unpack4(gv, v4); *(float4*)(L + stv * STEP + 320 + ptv * 4) = make_float4(v4[0], v4[1], v4[2], v4[3]); }
  };
  f32x2_t s01 = {0.f, 0.f}, s23 = {0.f, 0.f};
  gload(0); lwrite(0);
  __syncthreads();
  f32x4 qA[2][2], qB[2][2], qW[2][2], qK[2][2], qR[2][2]; float qv[2][2];
#define SLOAD(set, Lp, g) do { _Pragma("unroll") for (int _u = 0; _u < 2; ++_u) { const float* _Ls = (Lp) + ((g) * 2 + _u) * STEP; \
    qA[set][_u] = *(const f32x4*)(_Ls + 4 * c); qB[set][_u] = *(const f32x4*)(_Ls + 64 + 4 * c); qW[set][_u] = *(const f32x4*)(_Ls + 128 + 4 * c); \
    qK[set][_u] = *(const f32x4*)(_Ls + 192 + 4 * c); qR[set][_u] = *(const f32x4*)(_Ls + 256 + 4 * c); qv[set][_u] = _Ls[320 + rloc]; } } while (0)
#define SSTEP(set, u, stidx) do { \
    const f32x4 A = qA[set][u], Bv = qB[set][u], W = qW[set][u], Kv = qK[set][u], R = qR[set][u]; const float v = qv[set][u]; \
    const f32x2_t vv = {v, v}; \
    const f32x2_t A01 = {A[0], A[1]}, A23 = {A[2], A[3]}, B01 = {Bv[0], Bv[1]}, B23 = {Bv[2], Bv[3]}, W01 = {W[0], W[1]}, W23 = {W[2], W[3]}; \
    const f32x2_t K01 = {Kv[0], Kv[1]}, K23 = {Kv[2], Kv[3]}, R01 = {R[0], R[1]}, R23 = {R[2], R[3]}; \
    const f32x2_t pd2 = s01 * A01 + s23 * A23; \
    const f32x2_t t01 = s01 * W01 + vv * K01, t23 = s23 * W23 + vv * K23; \
    const float pdot = rowsum16(pd2[0] + pd2[1]); \
    const f32x2_t pp = {pdot, pdot}; \
    s01 = pp * B01 + t01; s23 = pp * B23 + t23; \
    const f32x2_t y2 = s01 * R01 + s23 * R23; \
    yp[stidx] = y2[0] + y2[1]; } while (0)
  for (int ch = 0; ch < 256; ++ch) {
    const float* L = lds + (ch & 1) * BUF;
    if (ch + 1 < 256) gload(ch + 1);
    float yp[16];
    SLOAD(0, L, 0);
#pragma unroll
    for (int g = 0; g < 8; g += 2) {
      SLOAD(1, L, g + 1);
      SSTEP(0, 0, g * 2); SSTEP(0, 1, g * 2 + 1);
      if (g + 2 < 8) SLOAD(0, L, g + 2);
      SSTEP(1, 0, g * 2 + 2); SSTEP(1, 1, g * 2 + 3);
    }
    float ykeep;
    {
      const bool m8 = (c & 8) != 0, m4 = (c & 4) != 0, m2 = (c & 2) != 0, m1 = (c & 1) != 0;
      float r8[8], r4[4], r2[2];
#pragma unroll
      for (int i = 0; i < 8; ++i) { const float keep = m8 ? yp[i + 8] : yp[i], send = m8 ? yp[i] : yp[i + 8]; r8[i] = keep + dppf<0x140>(send); }
#pragma unroll
      for (int i = 0; i < 4; ++i) { const float keep = m4 ? r8[i + 4] : r8[i], send = m4 ? r8[i] : r8[i + 4]; r4[i] = keep + dppf<0x141>(send); }
#pragma unroll
      for (int i = 0; i < 2; ++i) { const float keep = m2 ? r4[i + 2] : r4[i], send = m2 ? r4[i] : r4[i + 2]; r2[i] = keep + dppf<0x4E>(send); }
      { const float keep = m1 ? r2[1] : r2[0], send = m1 ? r2[0] : r2[1]; ykeep = keep + dppf<0xB1>(send); }
    }
    Y[base + (size_t)(ch * 16 + c) * 384 + row] = ykeep;
    if (ch + 1 < 256) lwrite((ch + 1) & 1);
    __syncthreads();
  }
#undef SLOAD
#undef SSTEP
}

__device__ void attn_task(const Params& p, int task) {
  const int lane = otid() & 63, r = lane & 31, hh = lane >> 5;
  const int bh = task >> 7, qt = 127 - (task & 127);
  const int b = bh / 6, h = bh - b * 6;
  const int t0 = qt * 32;
  const bf16_t* sbq = (const bf16_t*)(p.ws + OFF_SBQ); const bf16_t* sbk = (const bf16_t*)(p.ws + OFF_SBK); const bf16_t* sbvt = (const bf16_t*)(p.ws + OFF_SBVT);
  bf16x8 qf[4];
  {
    const bf16_t* qb = sbq + ((size_t)bh * 4096 + t0 + r) * 64 + 8 * hh;
#pragma unroll
    for (int ks = 0; ks < 4; ++ks) qf[ks] = *(const bf16x8*)(qb + 16 * ks);
  }
  f32x16 o0, o1;
#pragma unroll
  for (int i = 0; i < 16; ++i) { o0[i] = 0.f; o1[i] = 0.f; }
  float crun = 0.f;
  for (int kb = qt; kb >= 0; --kb) {
    const bf16_t* kp = sbk + ((size_t)bh * 4096 + kb * 32 + r) * 64 + 8 * hh;
    f32x16 s;
#pragma unroll
    for (int i = 0; i < 16; ++i) s[i] = 0.f;
#pragma unroll
    for (int ks = 0; ks < 4; ++ks) s = MFMA32(*(const bf16x8*)(kp + 16 * ks), qf[ks], s);
    const bool diag = (kb == qt);
    float C[16], tg[4], ptn[4], both[4], suf[4];
    bool cz[16];
#pragma unroll
    for (int g = 0; g < 4; ++g) {
      float run = 0.f;
#pragma unroll
      for (int i = 3; i >= 0; --i) {
        const int reg = 4 * g + i;
        const int key = i + 8 * g + 4 * hh;
        const bool causal = (!diag) || (key < r);
        cz[reg] = causal;
        const float L = causal ? -softplusf_(s[reg]) : 0.f;
        run += L;
        C[reg] = run;
      }
      tg[g] = run;
    }
#pragma unroll
    for (int g = 0; g < 4; ++g) { ptn[g] = __shfl_xor(tg[g], 32); both[g] = tg[g] + ptn[g]; }
    suf[3] = 0.f; suf[2] = both[3]; suf[1] = suf[2] + both[2]; suf[0] = suf[1] + both[1];
    float A[16];
#pragma unroll
    for (int g = 0; g < 4; ++g) {
      const float off = suf[g] + (hh == 0 ? ptn[g] : 0.f) + crun;
#pragma unroll
      for (int i = 0; i < 4; ++i) { const int reg = 4 * g + i; A[reg] = cz[reg] ? __expf(s[reg] + C[reg] + off) : 0.f; }
    }
    crun += suf[0] + both[0];
#pragma unroll
    for (int s2 = 0; s2 < 2; ++s2) {
      const bf16x8 pf = pack8(&A[8 * s2]);
      {
        const bf16_t* vp = sbvt + ((size_t)bh * 64 + r) * 4096 + kb * 32 + 16 * s2 + 4 * hh;
        const u32x2 lo = *(const u32x2*)vp, hi = *(const u32x2*)(vp + 8);
        u32x4 vv = {lo.x, lo.y, hi.x, hi.y};
        o0 = MFMA32(pf, *reinterpret_cast<bf16x8*>(&vv), o0);
      }
      {
        const bf16_t* vp = sbvt + ((size_t)bh * 64 + 32 + r) * 4096 + kb * 32 + 16 * s2 + 4 * hh;
        const u32x2 lo = *(const u32x2*)vp, hi = *(const u32x2*)(vp + 8);
        u32x4 vv = {lo.x, lo.y, hi.x, hi.y};
        o1 = MFMA32(pf, *reinterpret_cast<bf16x8*>(&vv), o1);
      }
    }
    if (__ballot(crun >= -110.f) == 0ull) break;
  }
  bf16_t* mix = (bf16_t*)(p.ws + OFF_HBUF);
#pragma unroll
  for (int reg = 0; reg < 16; ++reg) {
    const int q = (reg & 3) + 8 * (reg >> 2) + 4 * hh;
    bf16_t* d = mix + ((size_t)b * 4096 + t0 + q) * 1024 + 384 + h * 64 + r;
    d[0] = f2bf(o0[reg]); d[32] = f2bf(o1[reg]);
  }
}

__device__ void post_phase(const Params& p, int l, int gt, int nt) {
  const float* Y = (const float*)(p.ws + OFF_PROJR); const bf16_t* SV = (const bf16_t*)(p.ws + OFF_SV); const bf16_t* Gp = (const bf16_t*)(p.ws + OFF_G);
  const float* bonus = (const float*)(p.ws + OFF_BONUS);
  bf16_t* mix = (bf16_t*)(p.ws + OFF_HBUF);
  const int total = M_ * 96;
  for (int i = gt; i < total; i += nt) {
    const int tok = i / 96, cgp = i - tok * 96, c = cgp * 4, h = cgp >> 4;
    const size_t o = (size_t)tok * 384 + c;
    const float4 y = *(const float4*)(Y + o);
    float v4[4], g4[4]; unpack4(*(const u32x2*)(SV + o), v4); unpack4(*(const u32x2*)(Gp + o), g4);
    const float mean = rowsum16((y.x + y.y) + (y.z + y.w)) * (1.f / 64.f);
    const float d0 = y.x - mean, d1 = y.y - mean, d2 = y.z - mean, d3 = y.w - mean;
    const float var = rowsum16((d0 * d0 + d1 * d1) + (d2 * d2 + d3 * d3)) * (1.f / 64.f);
    const float rs = rsqrtf(var + 64e-5f);
    const float4 lw = *(const float4*)(p.lnx_w + l * 384 + c), lb = *(const float4*)(p.lnx_b + l * 384 + c);
    const float bo = bonus[(size_t)tok * 6 + h];
    *(u32x2*)(mix + (size_t)tok * 1024 + c) = pack4((d0 * rs * lw.x + lb.x + bo * v4[0]) * g4[0], (d1 * rs * lw.y + lb.y + bo * v4[1]) * g4[1],
                                                    (d2 * rs * lw.z + lb.z + bo * v4[2]) * g4[2], (d3 * rs * lw.w + lb.w + bo * v4[3]) * g4[3]);
  }
}

__global__ void __launch_bounds__(256, 2) fwd_megakernel(Params p) {
  __shared__ __attribute__((aligned(16))) unsigned char smem[65536];
  GridBar gb; gb.bar = (unsigned*)(p.ws + OFF_BAR); gb.nloc = 0u; gb.nx = 0u;
  gb.x = (unsigned)__builtin_amdgcn_s_getreg((3 << 11) | 20) & 0xFu;
  if (threadIdx.x == 0) (void)xb_add(&gb.bar[XB_XCNT(gb.x)], 1u);
  const int bid = blockIdx.x, G = gridDim.x;
#define wave (otid() >> 6)
#define gw (bid * 4 + (otid() >> 6))
#define gt (bid * 256 + otid())
  const int vb = (bid & 7) * (G >> 3) + (bid >> 3);
  const int nw = G * 4, ngt = G * 256;
  bf16_t* hbuf = (bf16_t*)(p.ws + OFF_HBUF);

  prep_phase(p, 0, vb, G, gt, ngt, smem);
  norm_phase(p.x, p.ln1_g, hbuf, gw, nw);
  grid_barrier(gb);
#pragma unroll 1
  for (int l = 0; l < 2; ++l) {
    if (l > 0) { norm_phase(p.out, p.ln1_g + 1024, hbuf, gw, nw); grid_barrier(gb); }
    gemm_phase<0>(p, l, vb, G, smem);
    grid_barrier(gb);
    for (int blk = bid; blk < 512; blk += G) rwkv_prep_task(p, l, (blk * 4 + wave) * 16, smem);
    grid_barrier(gb);
    if (bid < 192) scan_block(p, bid, smem);
    else {
      for (int task = (bid - 192) * 4 + wave; task < 6144; task += (G - 192) * 4) attn_task(p, task);
      for (int task = (bid - 192) * 4 + wave; task < 2048; task += (G - 192) * 4) pool_task(p, l, task * 16);
      if (l == 0) { __syncthreads(); prep_phase(p, 1, bid - 192, G - 192, (bid - 192) * 256 + otid(), (G - 192) * 256, smem); }
    }
    grid_barrier(gb);
    post_phase(p, l, gt, ngt);
    grid_barrier(gb);
    gemm_phase<1>(p, l, vb, G, smem);
    grid_barrier(gb);
    norm_phase(p.out, p.ln2_g + l * 1024, hbuf, gw, nw);
    grid_barrier(gb);
    gemm_phase<2>(p, l, vb, G, smem);
    grid_barrier(gb);
    gemm_phase<3>(p, l, vb, G, smem);
    if (l == 0) grid_barrier(gb);
  }
}

#undef wave
#undef gw
#undef gt

extern "C" void kernel_launch(void* const* d_in, const int* in_sizes, int n_in, void* d_out, int out_size, void* d_ws, size_t ws_size, hipStream_t stream) {
  static int grid_blocks = 0;
  if (!grid_blocks) {
    int dev = 0, cus = 0, per_cu = 0;
    (void)hipGetDevice(&dev);
    (void)hipDeviceGetAttribute(&cus, hipDeviceAttributeMultiprocessorCount, dev);
    (void)hipOccupancyMaxActiveBlocksPerMultiprocessor(&per_cu, fwd_megakernel, 256, 0);
    if (per_cu > 2) per_cu = 2;
    if (per_cu < 1) per_cu = 1;
    if (cus <= 0) cus = 256;
    grid_blocks = cus * per_cu;
    grid_blocks &= ~7;
  }
  Params p{};
  p.x = (const float*)d_in[0]; p.ln1_g = (const float*)d_in[1]; p.w_in = (const float*)d_in[2]; p.mu = (const float*)d_in[3]; p.w0 = (const float*)d_in[4];
  p.w2 = (const float*)d_in[5]; p.a0 = (const float*)d_in[6]; p.a2 = (const float*)d_in[7]; p.g2 = (const float*)d_in[8]; p.k_k = (const float*)d_in[9];
  p.k_a = (const float*)d_in[10]; p.r_k = (const float*)d_in[11]; p.lnx_w = (const float*)d_in[12]; p.lnx_b = (const float*)d_in[13]; p.v0 = (const float*)d_in[14];
  p.v1 = (const float*)d_in[15]; p.v2 = (const float*)d_in[16]; p.q_gain = (const float*)d_in[17]; p.k_gain = (const float*)d_in[18]; p.pool_w = (const float*)d_in[19];
  p.pool_b = (const float*)d_in[20]; p.pool_scale = (const float*)d_in[21]; p.w_out = (const float*)d_in[22]; p.ln2_g = (const float*)d_in[23];
  p.w_up = (const float*)d_in[24]; p.conv_w = (const float*)d_in[25]; p.conv_b = (const float*)d_in[26]; p.w_down = (const float*)d_in[27];
  p.out = (float*)d_out; p.ws = (unsigned char*)d_ws;
  (void)hipMemsetAsync(d_ws, 0, XB_BYTES, stream);
  void* args[] = {&p};
  hipError_t e = hipLaunchCooperativeKernel((const void*)fwd_megakernel, dim3(grid_blocks), dim3(256), args, 0, stream);
  if (e != hipSuccess) fprintf(stderr, "cooperative launch failed: %s (grid %d)\n", hipGetErrorString(e), grid_blocks);
}
```

```cpp
#include <hip/hip_runtime.h>
#include <stdint.h>
#include <cstdio>

typedef unsigned short bf16_t;
typedef short bf16x8 __attribute__((ext_vector_type(8)));
typedef float f32x4 __attribute__((ext_vector_type(4)));
typedef float f32x16 __attribute__((ext_vector_type(16)));
typedef unsigned u32x4 __attribute__((ext_vector_type(4)));
typedef unsigned u32x2 __attribute__((ext_vector_type(2)));

#define TID ((int)threadIdx.x)
__device__ __forceinline__ int otid() { int t = threadIdx.x; asm volatile("" : "+v"(t)); return t; }
constexpr int T_ = 4096, M_ = 32768;
constexpr size_t MiB = 1u << 20;
constexpr size_t OFF_BAR = 0;
constexpr size_t OFF_BONUS = 1 * MiB;
constexpr size_t OFF_SMALLW = 2 * MiB;
constexpr size_t OFF_WB = 3 * MiB;
constexpr size_t OFF_VFIRST = 51 * MiB;
constexpr size_t OFF_HBUF = 75 * MiB;
constexpr size_t OFF_G = 139 * MiB;
constexpr size_t OFF_SW = 163 * MiB;
constexpr size_t OFF_SR = 211 * MiB;
constexpr size_t OFF_SK = 235 * MiB;
constexpr size_t OFF_SV = 259 * MiB;
constexpr size_t OFF_SA = 283 * MiB;
constexpr size_t OFF_SB = 307 * MiB;
constexpr size_t OFF_PROJR = 331 * MiB;
constexpr size_t OFF_SBQ = 419 * MiB;
constexpr size_t OFF_SBK = 443 * MiB;
constexpr size_t OFF_SBVT = 467 * MiB;
constexpr size_t OFF_POOL = 491 * MiB;
constexpr size_t OFF_ACT = 163 * MiB;
constexpr size_t WB_LAYER = 12582912;
constexpr size_t WB_IN = 0, WB_OUT = 2883584, WB_UP = 3932160, WB_DOWN = 9699328;
constexpr size_t SW_LAYER = 139264;
constexpr size_t SW_W2 = 0, SW_A2 = 24576, SW_G2 = 49152, SW_POOL = 98304, SW_V1 = 114688, SW_V2 = 126976;

struct Params {
  const float* x; const float* ln1_g; const float* w_in; const float* mu; const float* w0; const float* w2; const float* a0; const float* a2; const float* g2;
  const float* k_k; const float* k_a; const float* r_k; const float* lnx_w; const float* lnx_b; const float* v0; const float* v1; const float* v2;
  const float* q_gain; const float* k_gain; const float* pool_w; const float* pool_b; const float* pool_scale; const float* w_out; const float* ln2_g;
  const float* w_up; const float* conv_w; const float* conv_b; const float* w_down;
  float* out; unsigned char* ws;
};

typedef __bf16 bf16x2_t __attribute__((ext_vector_type(2)));
typedef float f32x2_t __attribute__((ext_vector_type(2)));
__device__ __forceinline__ unsigned pk_bf16(float lo, float hi) { f32x2_t f = {lo, hi}; bf16x2_t b = __builtin_convertvector(f, bf16x2_t); return *reinterpret_cast<unsigned*>(&b); }
__device__ __forceinline__ float bf_lo(unsigned u) { return __uint_as_float(u << 16); }
__device__ __forceinline__ float bf_hi(unsigned u) { return __uint_as_float(u & 0xffff0000u); }
__device__ __forceinline__ bf16_t f2bf(float f) { return (bf16_t)(pk_bf16(f, 0.f) & 0xffffu); }
__device__ __forceinline__ bf16x8 pack8(const float* f) { u32x4 w = {pk_bf16(f[0], f[1]), pk_bf16(f[2], f[3]), pk_bf16(f[4], f[5]), pk_bf16(f[6], f[7])}; return *reinterpret_cast<bf16x8*>(&w); }
__device__ __forceinline__ void unpack8(u32x4 u, float* f) { f[0] = bf_lo(u.x); f[1] = bf_hi(u.x); f[2] = bf_lo(u.y); f[3] = bf_hi(u.y); f[4] = bf_lo(u.z); f[5] = bf_hi(u.z); f[6] = bf_lo(u.w); f[7] = bf_hi(u.w); }
__device__ __forceinline__ void unpack4(u32x2 u, float* f) { f[0] = bf_lo(u.x); f[1] = bf_hi(u.x); f[2] = bf_lo(u.y); f[3] = bf_hi(u.y); }
__device__ __forceinline__ u32x2 pack4(float a, float b, float c, float d) { u32x2 r = {pk_bf16(a, b), pk_bf16(c, d)}; return r; }
__device__ __forceinline__ float sigmoidf_(float x) { return __builtin_amdgcn_rcpf(1.f + __expf(-x)); }
__device__ __forceinline__ float softplusf_(float x) { return fmaxf(x, 0.f) + 0.69314718f * __builtin_amdgcn_logf(1.f + __expf(-fabsf(x))); }
__device__ __forceinline__ float tanhf_(float x) { float e = __expf(2.f * x); return 1.f - 2.f * __builtin_amdgcn_rcpf(e + 1.f); }
#define MFMA16(a, b, c) __builtin_amdgcn_mfma_f32_16x16x32_bf16((a), (b), (c), 0, 0, 0)
#define MFMA32(a, b, c) __builtin_amdgcn_mfma_f32_32x32x16_bf16((a), (b), (c), 0, 0, 0)

template <int CTRL> __device__ __forceinline__ float dppf(float x) { return __int_as_float(__builtin_amdgcn_update_dpp(0, __float_as_int(x), CTRL, 0xf, 0xf, true)); }
__device__ __forceinline__ float rowsum16(float x) {
  x += dppf<0xB1>(x);
  x += dppf<0x4E>(x);
  x += dppf<0x141>(x);
  x += dppf<0x140>(x);
  return x;
}
__device__ __forceinline__ float wavesum(float x) {
#pragma unroll
  for (int o = 32; o >= 1; o >>= 1) x += __shfl_xor(x, o);
  return x;
}

#define XB_XCNT(j) (64 * (1 + (j)))
#define XB_XSUB(j) (64 * (17 + (j)))
#define XB_XGEN(j) (64 * (33 + (j)))
#define XB_TOP (64 * 49)
#define XB_TOPGEN (64 * 50)
#define XB_BYTES (64 * 51 * 4)
__device__ __forceinline__ unsigned xb_ld(unsigned* p) { return __hip_atomic_load(p, __ATOMIC_RELAXED, __HIP_MEMORY_SCOPE_AGENT); }
__device__ __forceinline__ unsigned xb_add(unsigned* p, unsigned v) { return __hip_atomic_fetch_add(p, v, __ATOMIC_RELAXED, __HIP_MEMORY_SCOPE_AGENT); }
struct GridBar { unsigned* bar; unsigned x, nloc, nx; };
__device__ __forceinline__ void grid_barrier(GridBar& gb) {
  asm volatile("s_waitcnt vmcnt(0) lgkmcnt(0)" ::: "memory");
  __syncthreads();
  if (threadIdx.x == 0) {
    unsigned* bar = gb.bar;
    if (gb.nloc == 0u) {
      const unsigned G = gridDim.x;
      unsigned sum, cnt, mine;
      for (;;) {
        sum = 0u; cnt = 0u; mine = 0u;
#pragma unroll
        for (unsigned j = 0; j < 16; ++j) { const unsigned cc = xb_ld(&bar[XB_XCNT(j)]); sum += cc; cnt += (cc > 0u) ? 1u : 0u; mine = (j == gb.x) ? cc : mine; }
        if (sum == G) break;
        __builtin_amdgcn_s_sleep(1);
      }
      gb.nloc = mine; gb.nx = cnt;
    }
    const unsigned old = xb_add(&bar[XB_XSUB(gb.x)], 1u);
    const unsigned gen = old / gb.nloc;
    if (old + 1u == (gen + 1u) * gb.nloc) {
      __builtin_amdgcn_fence(__ATOMIC_RELEASE, "agent");
      asm volatile("s_waitcnt vmcnt(0)" ::: "memory");
      const unsigned og = xb_add(&bar[XB_TOP], 1u);
      const unsigned tg = og / gb.nx;
      if (og + 1u == (tg + 1u) * gb.nx) xb_add(&bar[XB_TOPGEN], 1u);
      else { while (xb_ld(&bar[XB_TOPGEN]) == tg) __builtin_amdgcn_s_sleep(1); }
      __builtin_amdgcn_fence(__ATOMIC_ACQUIRE, "agent");
      xb_add(&bar[XB_XGEN(gb.x)], 1u);
      asm volatile("s_waitcnt vmcnt(0)" ::: "memory");
    } else {
      while (xb_ld(&bar[XB_XGEN(gb.x)]) == gen) __builtin_amdgcn_s_sleep(1);
      __builtin_amdgcn_fence(__ATOMIC_ACQUIRE, "agent");
      asm volatile("s_waitcnt vmcnt(0)" ::: "memory");
    }
  }
  __syncthreads();
}

template <int PERM>
__device__ void transpose_big(const float* __restrict__ src, int K, int N, int Ndst, bf16_t* dst, int vb, int G, unsigned char* smem) {
  float* tile = (float*)smem;
  const int nkt = K >> 6, nnt = Ndst >> 6, ntile = nkt * nnt;
  const int tid_ = otid(); const int tl = tid_ & 63, th = tid_ >> 6;
  for (int tt = vb; tt < ntile; tt += G) {
    const int kt = tt % nkt, nt = tt / nkt;
    const int k0 = kt << 6, n0 = nt << 6;
    int sc;
    if (PERM == 0) sc = n0 + tl; else sc = (tl < 32) ? (nt * 32 + tl) : (2816 + nt * 32 + tl - 32);
#pragma unroll
    for (int i = 0; i < 16; ++i) { const int kk = i * 4 + th; tile[kk * 65 + tl] = src[(size_t)(k0 + kk) * N + sc]; }
    __syncthreads();
#pragma unroll
    for (int i = 0; i < 16; ++i) { const int nn = i * 4 + th; dst[(size_t)(n0 + nn) * K + k0 + tl] = f2bf(tile[tl * 65 + nn]); }
    __syncthreads();
  }
}
__device__ void transpose_small(const float* __restrict__ src, int K, int N, bf16_t* dst, int gt, int nt) {
  const int tot = K * N;
  for (int i = gt; i < tot; i += nt) { const int n = i / K, k = i - n * K; dst[i] = f2bf(src[(size_t)k * N + n]); }
}

__device__ void prep_phase(const Params& p, int part, int vb, int G, int gt, int nt, unsigned char* smem) {
  bf16_t* wb = (bf16_t*)(p.ws + OFF_WB);
  bf16_t* sw = (bf16_t*)(p.ws + OFF_SMALLW);
  for (int l = 0; l < 2; ++l) {
    bf16_t* w = wb + (size_t)l * WB_LAYER;
    const bool first = (l == 0);
    if ((part == 0) == first) {
      transpose_big<0>(p.w_in + (size_t)l * 1024 * 2816, 1024, 2816, 2816, w + WB_IN, vb, G, smem);
      bf16_t* s = sw + (size_t)l * SW_LAYER;
      transpose_small(p.w2 + (size_t)l * 64 * 384, 64, 384, s + SW_W2, gt, nt);
      transpose_small(p.a2 + (size_t)l * 64 * 384, 64, 384, s + SW_A2, gt, nt);
      transpose_small(p.g2 + (size_t)l * 128 * 384, 128, 384, s + SW_G2, gt, nt);
      for (int g = 0; g < 4; ++g) transpose_small(p.pool_w + (size_t)(l * 4 + g) * 4096, 64, 64, s + SW_POOL + g * 4096, gt, nt);
      if (l == 1) {
        transpose_small(p.v1, 384, 32, s + SW_V1, gt, nt);
        transpose_small(p.v2, 32, 384, s + SW_V2, gt, nt);
      }
    }
    if (part == 1) {
      transpose_big<0>(p.w_out + (size_t)l * 1024 * 1024, 1024, 1024, 1024, w + WB_OUT, vb, G, smem);
      transpose_big<1>(p.w_up + (size_t)l * 1024 * 5632, 1024, 5632, 5632, w + WB_UP, vb, G, smem);
      transpose_big<0>(p.w_down + (size_t)l * 2816 * 1024, 2816, 1024, 1024, w + WB_DOWN, vb, G, smem);
    }
  }
}

__device__ void norm_phase(const float* x, const float* __restrict__ g, bf16_t* h, int gw, int nw) {
  const int lane = otid() & 63;
  for (int row = gw; row < M_; row += nw) {
    const float4* xr = (const float4*)(x + (size_t)row * 1024);
    float4 v[4]; float ss = 0.f;
#pragma unroll
    for (int i = 0; i < 4; ++i) { { const f32x4 t_ = __builtin_nontemporal_load((const f32x4*)&xr[lane + 64 * i]); v[i] = make_float4(t_[0], t_[1], t_[2], t_[3]); } ss += v[i].x * v[i].x + v[i].y * v[i].y + v[i].z * v[i].z + v[i].w * v[i].w; }
    ss = wavesum(ss);
    const float rs = rsqrtf(ss * (1.f / 1024.f) + 1e-6f);
#pragma unroll
    for (int i = 0; i < 4; ++i) {
      const float4 gv = ((const float4*)g)[lane + 64 * i];
      *(u32x2*)(h + (size_t)row * 1024 + (lane + 64 * i) * 4) = pack4(v[i].x * rs * gv.x, v[i].y * rs * gv.y, v[i].z * rs * gv.z, v[i].w * rs * gv.w);
    }
  }
}

#define LAS __attribute__((address_space(3)))
__device__ __forceinline__ void stage_rc(int b, int& R, int& C) {
  R = b >> 7; C = (((b >> 4) & 7) ^ (R & 7)) * 8;
}
#define GSTAGE(A_, W_, ao_, wo_, buf, kt) do { const int _wb = __builtin_amdgcn_readfirstlane(tid >> 6) * 1024; _Pragma("unroll") for (int _i = 0; _i < 4; ++_i) { \
    __builtin_amdgcn_global_load_lds((const unsigned*)((A_) + (ao_)[_i] + (kt) * 64), (LAS unsigned*)((LAS unsigned char*)smem + (buf) * 32768 + _wb + _i * 4096), 16, 0, 0); \
    __builtin_amdgcn_global_load_lds((const unsigned*)((W_) + (wo_)[_i] + (kt) * 64), (LAS unsigned*)((LAS unsigned char*)smem + (buf) * 32768 + 16384 + _wb + _i * 4096), 16, 0, 0); } } while (0)
__device__ __forceinline__ void gemm_mainloop(const bf16_t* A, const bf16_t* W, const unsigned (&ao)[4], const unsigned (&wo)[4], int nk, unsigned char* smem, f32x4 (&acc)[4][4]) {
  const int tid = otid(), lane = tid & 63, wave = tid >> 6, wr = wave >> 1, wc = wave & 1, fr = lane & 15, fq = lane >> 4;
  const int foff0 = fr * 128 + ((fq ^ (fr & 7)) << 4), foff1 = fr * 128 + (((4 + fq) ^ (fr & 7)) << 4);
  const int aoff = (wr * 64) * 128, boff = 16384 + (wc * 64) * 128;
  asm volatile("s_waitcnt vmcnt(0)" ::: "memory");
  __syncthreads();
  for (int kt = 0; kt < nk; ++kt) {
    const int cb = kt & 1;
    unsigned char* cur = smem + cb * 32768;
    bf16x8 af[2][4], wf[2][4];
#pragma unroll
    for (int ks = 0; ks < 2; ++ks) {
#pragma unroll
      for (int mt = 0; mt < 4; ++mt) af[ks][mt] = *(const bf16x8*)(cur + aoff + mt * 2048 + (ks ? foff1 : foff0));
#pragma unroll
      for (int nt = 0; nt < 4; ++nt) wf[ks][nt] = *(const bf16x8*)(cur + boff + nt * 2048 + (ks ? foff1 : foff0));
    }
    __builtin_amdgcn_sched_barrier(0);
    if (kt + 1 < nk) GSTAGE(A, W, ao, wo, cb ^ 1, kt + 1);
#pragma unroll
    for (int ks = 0; ks < 2; ++ks) {
#pragma unroll
      for (int nt = 0; nt < 4; ++nt)
#pragma unroll
        for (int mt = 0; mt < 4; ++mt) acc[nt][mt] = MFMA16(wf[ks][nt], af[ks][mt], acc[nt][mt]);
    }
    __builtin_amdgcn_sched_barrier(0);
    asm volatile("s_waitcnt vmcnt(0)" ::: "memory");
    __syncthreads();
  }
}

template <int MODE>
__device__ void gemm_phase(const Params& p, int l, int vb, int G, unsigned char* smem) {
  const int tid = otid(), lane = tid & 63, wave = tid >> 6, wr = wave >> 1, wc = wave & 1, fr = lane & 15, fq = lane >> 4;
  const bf16_t* wbl = (const bf16_t*)(p.ws + OFF_WB) + (size_t)l * WB_LAYER;
  const bf16_t* A; const bf16_t* W; int K, nN, nM, lda;
  if (MODE == 0) { A = (const bf16_t*)(p.ws + OFF_HBUF); W = wbl + WB_IN; K = 1024; nN = 22; nM = 256; lda = 1024; }
  if (MODE == 1) { A = (const bf16_t*)(p.ws + OFF_HBUF); W = wbl + WB_OUT; K = 1024; nN = 8; nM = 256; lda = 1024; }
  if (MODE == 2) { A = (const bf16_t*)(p.ws + OFF_HBUF); W = wbl + WB_UP; K = 1024; nN = 44; nM = 264; lda = 1024; }
  if (MODE == 3) { A = (const bf16_t*)(p.ws + OFF_ACT); W = wbl + WB_DOWN; K = 2816; nN = 8; nM = 256; lda = 2816; }
  const int ntile = nM * nN, nk = K >> 6;
  auto tile_pmn = [&](int tile, int& pm_, int& pn_) { const int grp = tile / (8 * nN), within = tile - grp * (8 * nN); pm_ = grp * 8 + (within & 7); pn_ = within >> 3; };
  auto tile_offs = [&](int pm_, int pn_, unsigned (&ao_)[4], unsigned (&wo_)[4]) {
    int tb_ = 0, ti_ = 0;
    if (MODE == 2) { tb_ = pm_ / 33; ti_ = pm_ - tb_ * 33; }
#pragma unroll
    for (int i = 0; i < 4; ++i) {
      int r, cc; stage_rc(tid * 16 + i * 4096, r, cc);
      unsigned grow;
      if (MODE == 2) { int t = 126 * ti_ - 2 + r; t = t < 0 ? 0 : (t > 4095 ? 4095 : t); grow = (unsigned)(tb_ * 4096 + t); }
      else grow = (unsigned)(pm_ * 128 + r);
      ao_[i] = grow * (unsigned)lda + (unsigned)cc;
      wo_[i] = (unsigned)(pn_ * 128 + r) * (unsigned)K + (unsigned)cc;
    }
  };
  unsigned ao[4], wo[4];
  int pm = 0, pn = 0;
  if (vb < ntile) { tile_pmn(vb, pm, pn); tile_offs(pm, pn, ao, wo); GSTAGE(A, W, ao, wo, 0, 0); }
  for (int tile = vb; tile < ntile; tile += G) {
    const int n0 = pn * 128;
    int tb = 0, ti = 0;
    if (MODE == 2) { tb = pm / 33; ti = pm - tb * 33; }
    f32x4 acc[4][4];
#pragma unroll
    for (int a = 0; a < 4; ++a)
#pragma unroll
      for (int b = 0; b < 4; ++b) acc[a][b] = (f32x4){0.f, 0.f, 0.f, 0.f};
    gemm_mainloop(A, W, ao, wo, nk, smem, acc);
    const int cpm = pm; (void)cpm;
    int npm = 0, npn = 0;
    const bool has_next = (tile + G) < ntile;
    if (has_next) { tile_pmn(tile + G, npm, npn); tile_offs(npm, npn, ao, wo); }
    if (MODE != 2) { if (has_next) GSTAGE(A, W, ao, wo, 0, 0); }

    if (MODE == 0) {
      const int cg = (n0 + wc * 64) >> 6;
#pragma unroll
      for (int mt = 0; mt < 4; ++mt) {
        const int tok = pm * 128 + wr * 64 + mt * 16 + fr;
        const int b = tok >> 12, t = tok & 4095;
        if (cg < 22) {
          bf16_t* d = (bf16_t*)(p.ws + OFF_PROJR) + (size_t)tok * 1408 + cg * 64 + fq * 4;
#pragma unroll
          for (int nt = 0; nt < 4; ++nt) *(u32x2*)(d + nt * 16) = pack4(acc[nt][mt][0], acc[nt][mt][1], acc[nt][mt][2], acc[nt][mt][3]);
        } else if (cg < 34) {
          const bool isq = cg < 28; const int head = isq ? cg - 22 : cg - 28;
          const float* gain = (isq ? p.q_gain : p.k_gain) + l * 64;
          float ss = 0.f;
#pragma unroll
          for (int nt = 0; nt < 4; ++nt)
#pragma unroll
            for (int j = 0; j < 4; ++j) ss += acc[nt][mt][j] * acc[nt][mt][j];
          ss += __shfl_xor(ss, 16); ss += __shfl_xor(ss, 32);
          const float rs = rsqrtf(ss * (1.f / 64.f) + 1e-6f) * (isq ? 0.125f : 1.f);
          bf16_t* d = (bf16_t*)(p.ws + (isq ? OFF_SBQ : OFF_SBK)) + ((size_t)(b * 6 + head) * 4096 + t) * 64 + fq * 4;
#pragma unroll
          for (int nt = 0; nt < 4; ++nt) {
            const float4 gv = *(const float4*)(gain + nt * 16 + fq * 4);
            *(u32x2*)(d + nt * 16) = pack4(acc[nt][mt][0] * rs * gv.x, acc[nt][mt][1] * rs * gv.y, acc[nt][mt][2] * rs * gv.z, acc[nt][mt][3] * rs * gv.w);
          }
        } else if (cg < 40) {
          const int head = cg - 34;
          bf16_t* d = (bf16_t*)(p.ws + OFF_SBVT) + ((size_t)(b * 6 + head) * 64 + fq * 4) * 4096 + t;
#pragma unroll
          for (int nt = 0; nt < 4; ++nt)
#pragma unroll
            for (int j = 0; j < 4; ++j) d[(size_t)(nt * 16 + j) * 4096] = f2bf(acc[nt][mt][j]);
        } else {
          bf16_t* d = (bf16_t*)(p.ws + OFF_POOL) + (size_t)tok * 256 + (cg - 40) * 64 + fq * 4;
#pragma unroll
          for (int nt = 0; nt < 4; ++nt) *(u32x2*)(d + nt * 16) = pack4(acc[nt][mt][0], acc[nt][mt][1], acc[nt][mt][2], acc[nt][mt][3]);
        }
      }
    }
    if (MODE == 1 || MODE == 3) {
      const float* resid = (MODE == 1 && l == 0) ? p.x : p.out;
#pragma unroll
      for (int mh = 0; mh < 2; ++mh) {
        float4 rv[2][4];
#pragma unroll
        for (int m2 = 0; m2 < 2; ++m2) {
          const size_t tok = (size_t)pm * 128 + wr * 64 + (mh * 2 + m2) * 16 + fr;
#pragma unroll
          for (int nt = 0; nt < 4; ++nt) rv[m2][nt] = *(const float4*)(resid + tok * 1024 + n0 + wc * 64 + nt * 16 + fq * 4);
        }
#pragma unroll
        for (int m2 = 0; m2 < 2; ++m2) {
          const int mt = mh * 2 + m2;
          const size_t tok = (size_t)pm * 128 + wr * 64 + mt * 16 + fr;
#pragma unroll
          for (int nt = 0; nt < 4; ++nt) {
            float4 ov; ov.x = rv[m2][nt].x + acc[nt][mt][0]; ov.y = rv[m2][nt].y + acc[nt][mt][1]; ov.z = rv[m2][nt].z + acc[nt][mt][2]; ov.w = rv[m2][nt].w + acc[nt][mt][3];
            *(float4*)(p.out + tok * 1024 + n0 + wc * 64 + nt * 16 + fq * 4) = ov;
          }
        }
      }
    }
    if (MODE == 2) {
      float* halo = (float*)(smem + 32768);
      if (ti == 0 && wr == 0 && fr < 2) {
#pragma unroll
        for (int nt = 0; nt < 4; ++nt) acc[nt][0] = (f32x4){0.f, 0.f, 0.f, 0.f};
      }
      if (wr == 0 && fr >= 14) {
#pragma unroll
        for (int nt = 0; nt < 4; ++nt) *(f32x4*)(halo + (wc * 2 + (fr - 14)) * 64 + nt * 16 + fq * 4) = acc[nt][3];
      }
      __syncthreads();
      f32x4 xm1[4];
#pragma unroll
      for (int nt = 0; nt < 4; ++nt) {
        xm1[nt] = (f32x4){0.f, 0.f, 0.f, 0.f};
        if (wr == 1 && fr >= 14) xm1[nt] = *(const f32x4*)(halo + (wc * 2 + (fr - 14)) * 64 + nt * 16 + fq * 4);
      }
      __syncthreads();
      if (has_next) GSTAGE(A, W, ao, wo, 0, 0);
      const int Gc = (n0 + wc * 64) >> 6;
      const float* cw = p.conv_w + (size_t)l * 3 * 5632;
      const float* cb = p.conv_b + (size_t)l * 5632;
      bf16_t* actp = (bf16_t*)(p.ws + OFF_ACT);
#pragma unroll
      for (int nt = 0; nt < 2; ++nt) {
        const int ch = 32 * Gc + nt * 16 + fq * 4;
        const float4 cbg = *(const float4*)(cb + ch), cbv = *(const float4*)(cb + 2816 + ch);
        float4 cwg[3], cwv[3];
#pragma unroll
        for (int i = 0; i < 3; ++i) { cwg[i] = *(const float4*)(cw + i * 5632 + ch); cwv[i] = *(const float4*)(cw + i * 5632 + 2816 + ch); }
#pragma unroll
        for (int mt = 0; mt < 4; ++mt) {
          const int rt = wr * 64 + mt * 16 + fr;
          const int t = 126 * ti - 2 + rt;
          const bool valid = (rt >= 2) && (t < 4096);
          float o[4];
#pragma unroll
          for (int j = 0; j < 4; ++j) {
            float cvv[2];
#pragma unroll
            for (int gvi = 0; gvi < 2; ++gvi) {
              const int n2 = nt + 2 * gvi;
              const float x0 = acc[n2][mt][j];
              const float xp = (mt == 0) ? xm1[n2][j] : acc[n2][mt == 0 ? 0 : mt - 1][j];
              const float p1 = dppf<0x121>((fr == 15) ? xp : x0);
              const float p2 = dppf<0x122>((fr >= 14) ? xp : x0);
              const float4* wv = gvi ? cwv : cwg;
              const float bias = gvi ? ((const float*)&cbv)[j] : ((const float*)&cbg)[j];
              cvv[gvi] = bias + ((const float*)&wv[0])[j] * p2 + ((const float*)&wv[1])[j] * p1 + ((const float*)&wv[2])[j] * x0;
            }
            o[j] = cvv[0] * sigmoidf_(cvv[0]) * cvv[1];
          }
          if (valid) *(u32x2*)(actp + ((size_t)tb * 4096 + t) * 2816 + ch) = pack4(o[0], o[1], o[2], o[3]);
        }
      }
    }
    pm = npm; pn = npn;
  }
#undef GSTAGE
}

__device__ void rwkv_prep_task(const Params& p, int l, int tok0, unsigned char* smem) {
  const int lane = otid() & 63, fr = lane & 15, fq = lane >> 4;
  const int tok = tok0 + fr, t = tok & 4095;
  const bool hasprev = t > 0;
  const bf16_t* cur = (const bf16_t*)(p.ws + OFF_PROJR) + (size_t)tok * 1408;
  const bf16_t* prv = cur - (hasprev ? 1408 : 0);
  const float* mu = p.mu + l * 1408;
  const bf16_t* sw = (const bf16_t*)(p.ws + OFF_SMALLW) + (size_t)l * SW_LAYER;
  auto shift8 = [&](int c, float* o) {
    u32x4 uc = *(const u32x4*)(cur + c); u32x4 up = *(const u32x4*)(prv + c);
    float fc[8], fp[8]; unpack8(uc, fc); unpack8(up, fp);
    const float4 m0 = *(const float4*)(mu + c), m1 = *(const float4*)(mu + c + 4);
    const float m[8] = {m0.x, m0.y, m0.z, m0.w, m1.x, m1.y, m1.z, m1.w};
#pragma unroll
    for (int i = 0; i < 8; ++i) { const float pv = hasprev ? fp[i] : 0.f; o[i] = fc[i] + (pv - fc[i]) * m[i]; }
  };
  auto shift4 = [&](int c, float* o) {
    u32x2 uc = *(const u32x2*)(cur + c); u32x2 up = *(const u32x2*)(prv + c);
    float fc[4], fp[4]; unpack4(uc, fc); unpack4(up, fp);
    const float4 m0 = *(const float4*)(mu + c);
    const float m[4] = {m0.x, m0.y, m0.z, m0.w};
#pragma unroll
    for (int i = 0; i < 4; ++i) { const float pv = hasprev ? fp[i] : 0.f; o[i] = fc[i] + (pv - fc[i]) * m[i]; }
  };
  bf16x8 Bw[2], Ba[2], Bg[4], Bu;
  {
    float o[8];
#pragma unroll
    for (int ks = 0; ks < 2; ++ks) {
      shift8(1152 + ks * 32 + fq * 8, o);
#pragma unroll
      for (int i = 0; i < 8; ++i) o[i] = tanhf_(o[i]);
      Bw[ks] = pack8(o);
      shift8(1216 + ks * 32 + fq * 8, o);
      Ba[ks] = pack8(o);
    }
#pragma unroll
    for (int ks = 0; ks < 4; ++ks) {
      shift8(1280 + ks * 32 + fq * 8, o);
#pragma unroll
      for (int i = 0; i < 8; ++i) o[i] = sigmoidf_(o[i]);
      Bg[ks] = pack8(o);
    }
  }
  if (l == 1) {
    f32x4 u0 = {0.f, 0.f, 0.f, 0.f}, u1 = {0.f, 0.f, 0.f, 0.f};
    const bf16_t* v1t = sw + SW_V1;
#pragma unroll 2
    for (int ks = 0; ks < 12; ++ks) {
      float o[8]; shift8(768 + ks * 32 + fq * 8, o);
      const bf16x8 bv = pack8(o);
      const bf16x8 a0 = *(const bf16x8*)(v1t + (size_t)fr * 384 + ks * 32 + fq * 8);
      const bf16x8 a1 = *(const bf16x8*)(v1t + (size_t)(16 + fr) * 384 + ks * 32 + fq * 8);
      u0 = MFMA16(a0, bv, u0); u1 = MFMA16(a1, bv, u1);
    }
    const float uu[8] = {u0[0], u0[1], u0[2], u0[3], u1[0], u1[1], u1[2], u1[3]};
    Bu = pack8(uu);
  }
  const float* w0 = p.w0 + l * 384; const float* a0p = p.a0 + l * 384; const float* kkp = p.k_k + l * 384; const float* kap = p.k_a + l * 384;
  const float* rkp = p.r_k + l * 384; const float* v0p = p.v0;
  bf16_t* SR = (bf16_t*)(p.ws + OFF_SR); bf16_t* SK = (bf16_t*)(p.ws + OFF_SK); bf16_t* SV = (bf16_t*)(p.ws + OFF_SV);
  bf16_t* SA = (bf16_t*)(p.ws + OFF_SA); bf16_t* SBp = (bf16_t*)(p.ws + OFF_SB); bf16_t* Gp = (bf16_t*)(p.ws + OFF_G);
  bf16_t* VF = (bf16_t*)(p.ws + OFF_VFIRST); bf16_t* SWp = (bf16_t*)(p.ws + OFF_SW); float* bonus = (float*)(p.ws + OFF_BONUS);
  const int stid = otid();
#pragma unroll 1
  for (int h = 0; h < 6; ++h) {
    __syncthreads();
    {
      u32x4 t0, t1, t2, t3;
      { const int q0 = stid, q1 = stid + 256;
        t0 = *(const u32x4*)(sw + SW_W2 + (size_t)(h * 64 + (q0 >> 3)) * 64 + (q0 & 7) * 8); t1 = *(const u32x4*)(sw + SW_W2 + (size_t)(h * 64 + (q1 >> 3)) * 64 + (q1 & 7) * 8);
        t2 = *(const u32x4*)(sw + SW_A2 + (size_t)(h * 64 + (q0 >> 3)) * 64 + (q0 & 7) * 8); t3 = *(const u32x4*)(sw + SW_A2 + (size_t)(h * 64 + (q1 >> 3)) * 64 + (q1 & 7) * 8);
        *(u32x4*)(smem + (q0 >> 3) * 144 + (q0 & 7) * 16) = t0; *(u32x4*)(smem + (q1 >> 3) * 144 + (q1 & 7) * 16) = t1;
        *(u32x4*)(smem + 9216 + (q0 >> 3) * 144 + (q0 & 7) * 16) = t2; *(u32x4*)(smem + 9216 + (q1 >> 3) * 144 + (q1 & 7) * 16) = t3; }
      __builtin_amdgcn_sched_barrier(0);
      { const int q0 = stid, q1 = stid + 256, q2 = stid + 512, q3 = stid + 768;
        t0 = *(const u32x4*)(sw + SW_G2 + (size_t)(h * 64 + (q0 >> 4)) * 128 + (q0 & 15) * 8); t1 = *(const u32x4*)(sw + SW_G2 + (size_t)(h * 64 + (q1 >> 4)) * 128 + (q1 & 15) * 8);
        t2 = *(const u32x4*)(sw + SW_G2 + (size_t)(h * 64 + (q2 >> 4)) * 128 + (q2 & 15) * 8); t3 = *(const u32x4*)(sw + SW_G2 + (size_t)(h * 64 + (q3 >> 4)) * 128 + (q3 & 15) * 8);
        *(u32x4*)(smem + 18432 + (q0 >> 4) * 272 + (q0 & 15) * 16) = t0; *(u32x4*)(smem + 18432 + (q1 >> 4) * 272 + (q1 & 15) * 16) = t1;
        *(u32x4*)(smem + 18432 + (q2 >> 4) * 272 + (q2 & 15) * 16) = t2; *(u32x4*)(smem + 18432 + (q3 >> 4) * 272 + (q3 & 15) * 16) = t3; }
    }
    __syncthreads();
    const int cb = h * 64 + 8 * fq;
    __builtin_amdgcn_sched_barrier(0);
    float ss = 0.f;
    {
      float k16[16];
      shift8(384 + cb, k16); shift8(384 + cb + 32, k16 + 8);
#pragma unroll
      for (int q = 0; q < 4; ++q) {
        const float4 kkv = *(const float4*)(kkp + cb + 32 * (q >> 1) + 4 * (q & 1));
        const float x0 = k16[4 * q] * kkv.x, x1 = k16[4 * q + 1] * kkv.y, x2 = k16[4 * q + 2] * kkv.z, x3 = k16[4 * q + 3] * kkv.w;
        ss += x0 * x0 + x1 * x1 + x2 * x2 + x3 * x3;
      }
    }
    ss += __shfl_xor(ss, 16); ss += __shfl_xor(ss, 32);
    const float inv = 1.f / fmaxf(sqrtf(ss), 1e-12f);
    float bsum = 0.f;
#pragma unroll 1
    for (int half = 0; half < 2; ++half) {
      f32x4 lw[2], la[2], lg[2], lv[2];
#pragma unroll
      for (int n2 = 0; n2 < 2; ++n2) {
        const int nt = 2 * half + n2;
        lw[n2] = (f32x4){0.f, 0.f, 0.f, 0.f}; la[n2] = lw[n2]; lg[n2] = lw[n2]; lv[n2] = lw[n2];
        const int rloc = 32 * half + 8 * (fr >> 2) + 4 * n2 + (fr & 3);
        const int crow = h * 64 + rloc;
#pragma unroll
        for (int ks = 0; ks < 2; ++ks) {
          lw[n2] = MFMA16(*(const bf16x8*)(smem + rloc * 144 + (ks * 4 + fq) * 16), Bw[ks], lw[n2]);
          la[n2] = MFMA16(*(const bf16x8*)(smem + 9216 + rloc * 144 + (ks * 4 + fq) * 16), Ba[ks], la[n2]);
        }
#pragma unroll
        for (int ks = 0; ks < 4; ++ks) lg[n2] = MFMA16(*(const bf16x8*)(smem + 18432 + rloc * 272 + (ks * 4 + fq) * 16), Bg[ks], lg[n2]);
        if (l == 1) {
          const u32x2 lo = *(const u32x2*)(sw + SW_V2 + (size_t)crow * 32 + 4 * fq);
          const u32x2 hi = *(const u32x2*)(sw + SW_V2 + (size_t)crow * 32 + 16 + 4 * fq);
          u32x4 av = {lo.x, lo.y, hi.x, hi.y};
          lv[n2] = MFMA16(*reinterpret_cast<bf16x8*>(&av), Bu, lv[n2]);
        }
      }
      const int c8 = cb + 32 * half;
      const size_t o = (size_t)tok * 384 + c8;
      float r8[8], v8[8], k8[8], w0a[8], a0a[8], kaa[8], rka[8], kka[8];
      shift8(c8, r8); shift8(768 + c8, v8); shift8(384 + c8, k8);
#pragma unroll
      for (int q = 0; q < 2; ++q) {
        const float4 t0 = *(const float4*)(w0 + c8 + 4 * q), t1 = *(const float4*)(a0p + c8 + 4 * q), t2 = *(const float4*)(kap + c8 + 4 * q), t3 = *(const float4*)(rkp + c8 + 4 * q);
        const float4 t4 = *(const float4*)(kkp + c8 + 4 * q);
        kka[4 * q] = t4.x; kka[4 * q + 1] = t4.y; kka[4 * q + 2] = t4.z; kka[4 * q + 3] = t4.w;
        w0a[4 * q] = t0.x; w0a[4 * q + 1] = t0.y; w0a[4 * q + 2] = t0.z; w0a[4 * q + 3] = t0.w;
        a0a[4 * q] = t1.x; a0a[4 * q + 1] = t1.y; a0a[4 * q + 2] = t1.z; a0a[4 * q + 3] = t1.w;
        kaa[4 * q] = t2.x; kaa[4 * q + 1] = t2.y; kaa[4 * q + 2] = t2.z; kaa[4 * q + 3] = t2.w;
        rka[4 * q] = t3.x; rka[4 * q + 1] = t3.y; rka[4 * q + 2] = t3.z; rka[4 * q + 3] = t3.w;
      }
      if (l == 1) {
        float vf[8], v0a[8]; unpack8(*(const u32x4*)(VF + o), vf);
        const float4 t0 = *(const float4*)(v0p + c8), t1 = *(const float4*)(v0p + c8 + 4);
        v0a[0] = t0.x; v0a[1] = t0.y; v0a[2] = t0.z; v0a[3] = t0.w; v0a[4] = t1.x; v0a[5] = t1.y; v0a[6] = t1.z; v0a[7] = t1.w;
#pragma unroll
        for (int e8 = 0; e8 < 8; ++e8) v8[e8] = v8[e8] + (vf[e8] - v8[e8]) * sigmoidf_(v0a[e8] + lv[e8 >> 2][e8 & 3]);
      } else {
        *(bf16x8*)(VF + o) = pack8(v8);
      }
      float dec[8], kf[8], an[8], bn[8], gg[8];
#pragma unroll
      for (int e8 = 0; e8 < 8; ++e8) {
        const int nt = e8 >> 2, j = e8 & 3, e = 8 * half + e8;
        dec[e8] = 1.f - __expf(-0.60653066f * sigmoidf_(w0a[e8] + lw[nt][j]));
        const float sa = sigmoidf_(a0a[e8] + la[nt][j]);
        const float kn = k8[e8] * kka[e8] * inv;
        an[e8] = -kn; bn[e8] = kn * sa;
        kf[e8] = k8[e8] * (1.f + (sa - 1.f) * kaa[e8]);
        bsum += r8[e8] * kf[e8] * rka[e8];
        gg[e8] = lg[nt][j];
      }
      *(bf16x8*)(SWp + o) = pack8(dec);
      *(bf16x8*)(SR + o) = pack8(r8);
      *(bf16x8*)(SK + o) = pack8(kf);
      *(bf16x8*)(SV + o) = pack8(v8);
      *(bf16x8*)(Gp + o) = pack8(gg);
      *(bf16x8*)(SA + o) = pack8(an);
      *(bf16x8*)(SBp + o) = pack8(bn);
    }
    bsum += __shfl_xor(bsum, 16); bsum += __shfl_xor(bsum, 32);
    if (fq == 0) bonus[(size_t)tok * 6 + h] = bsum;
  }
}

__device__ void pool_task(const Params& p, int l, int tok0) {
  const int lane = otid() & 63, fr = lane & 15, fq = lane >> 4;
  const int tok = tok0 + fr, t = tok & 4095;
  const bf16_t* u = (const bf16_t*)(p.ws + OFF_POOL) + (size_t)tok * 256;
  const bf16_t* pt = (const bf16_t*)(p.ws + OFF_SMALLW) + (size_t)l * SW_LAYER + SW_POOL;
  bf16_t* mix = (bf16_t*)(p.ws + OFF_HBUF);
#pragma unroll
  for (int g = 0; g < 4; ++g) {
    const int w = 2 << g;
    const int cnt = (t + 1) < w ? (t + 1) : w;
    const float icnt = 1.f / (float)cnt;
    bf16x8 B[2];
#pragma unroll
    for (int ks = 0; ks < 2; ++ks) {
      const int c = g * 64 + ks * 32 + fq * 8;
      float s[8], f[8], u0[8];
      unpack8(*(const u32x4*)(u + c), u0);
#pragma unroll
      for (int i = 0; i < 8; ++i) s[i] = u0[i];
#pragma unroll
      for (int d0 = 1; d0 < w; d0 += 8) {
        u32x4 wr_[8];
#pragma unroll
        for (int q = 0; q < 8; ++q) { const int d = d0 + q; if (d < w) { const int dd = d < cnt ? d : 0; wr_[q] = *(const u32x4*)(u + c - (size_t)dd * 256); } }
#pragma unroll
        for (int q = 0; q < 8; ++q) { const int d = d0 + q; if (d < w) { unpack8(wr_[q], f);
#pragma unroll
          for (int i = 0; i < 8; ++i) s[i] += (d < cnt) ? f[i] : 0.f; } }
      }
#pragma unroll
      for (int i = 0; i < 8; ++i) s[i] = s[i] * icnt - u0[i];
      B[ks] = pack8(s);
    }
    float yo[16];
#pragma unroll
    for (int nt = 0; nt < 4; ++nt) {
      f32x4 acc = {0.f, 0.f, 0.f, 0.f};
      const int drow = 32 * (nt >> 1) + 8 * (fr >> 2) + 4 * (nt & 1) + (fr & 3);
#pragma unroll
      for (int ks = 0; ks < 2; ++ks) acc = MFMA16(*(const bf16x8*)(pt + (size_t)g * 4096 + (size_t)drow * 64 + ks * 32 + fq * 8), B[ks], acc);
      const int d = 32 * (nt >> 1) + 8 * fq + 4 * (nt & 1);
      const float4 bv = *(const float4*)(p.pool_b + (size_t)(l * 4 + g) * 64 + d);
      const float4 sv = *(const float4*)(p.pool_scale + (size_t)l * 256 + g * 64 + d);
      yo[4 * nt] = (acc[0] + bv.x) * sv.x; yo[4 * nt + 1] = (acc[1] + bv.y) * sv.y; yo[4 * nt + 2] = (acc[2] + bv.z) * sv.z; yo[4 * nt + 3] = (acc[3] + bv.w) * sv.w;
    }
    *(bf16x8*)(mix + (size_t)tok * 1024 + 768 + g * 64 + 8 * fq) = pack8(yo);
    *(bf16x8*)(mix + (size_t)tok * 1024 + 768 + g * 64 + 32 + 8 * fq) = pack8(yo + 8);
  }
}

__device__ void scan_block(const Params& p, int sb, unsigned char* smem) {
  const int tid = otid(), lane = tid & 63, wave = tid >> 6, rr = lane >> 4, c = lane & 15;
  const int bh = sb >> 2, rq = sb & 3, b = bh / 6, h = bh - b * 6;
  const int rloc = wave * 4 + rr;
  const int row = rq * 16 + rloc;
  const size_t base = (size_t)b * 4096 * 384 + h * 64;
  const bf16_t* SR = (const bf16_t*)(p.ws + OFF_SR); const bf16_t* SK = (const bf16_t*)(p.ws + OFF_SK); const bf16_t* SV = (const bf16_t*)(p.ws + OFF_SV);
  const bf16_t* SA = (const bf16_t*)(p.ws + OFF_SA); const bf16_t* SBp = (const bf16_t*)(p.ws + OFF_SB); const bf16_t* SWp = (const bf16_t*)(p.ws + OFF_SW);
  float* Y = (float*)(p.ws + OFF_PROJR);
  float* lds = (float*)smem;
  constexpr int STEP = 336, BUF = 16 * STEP;
  const int q0 = tid, q1 = tid + 256;
  const int arr0 = q0 >> 7, st0 = (q0 & 127) >> 3, pt0 = q0 & 7;
  const int arr1 = q1 >> 7, st1 = (q1 & 127) >> 3, pt1 = q1 & 7;
  const bf16_t* src0 = (arr0 == 0 ? SA : SBp) + base + (size_t)st0 * 384 + pt0 * 8;
  const bf16_t* src1 = (arr1 == 2 ? SK : SR) + base + (size_t)st1 * 384 + pt1 * 8;
  const int slot0 = (arr0 == 0 ? 0 : 64), slot1 = (arr1 == 2 ? 192 : 256);
  const int stw = (tid & 127) >> 3, ptw = tid & 7;
  const bf16_t* srcw = SWp + base + (size_t)stw * 384 + ptw * 8;
  const int stv = (tid & 63) >> 2, ptv = tid & 3;
  const bf16_t* srcv = SV + base + (size_t)stv * 384 + rq * 16 + ptv * 4;
  u32x4 g0, g1, gw = {0u, 0u, 0u, 0u}; u32x2 gv = {0u, 0u};
  auto gload = [&](int ch) {
    const size_t o = (size_t)ch * 16 * 384;
    g0 = *(const u32x4*)(src0 + o); g1 = *(const u32x4*)(src1 + o); if (tid < 128) gw = *(const u32x4*)(srcw + o);
    if (tid < 64) gv = *(const u32x2*)(srcv + o);
  };
  auto lwrite = [&](int bufi) {
    float* L = lds + bufi * BUF;
    float f[8];
    unpack8(g0, f);
    *(float4*)(L + st0 * STEP + slot0 + pt0 * 8) = make_float4(f[0], f[1], f[2], f[3]); *(float4*)(L + st0 * STEP + slot0 + pt0 * 8 + 4) = make_float4(f[4], f[5], f[6], f[7]);
    unpack8(g1, f);
    *(float4*)(L + st1 * STEP + slot1 + pt1 * 8) = make_float4(f[0], f[1], f[2], f[3]); *(float4*)(L + st1 * STEP + slot1 + pt1 * 8 + 4) = make_float4(f[4], f[5], f[6], f[7]);
    if (tid < 128) { unpack8(gw, f); *(float4*)(L + stw * STEP + 128 + ptw * 8) = make_float4(1.f - f[0], 1.f - f[1], 1.f - f[2], 1.f - f[3]); *(float4*)(L + stw * STEP + 128 + ptw * 8 + 4) = make_float4(1.f - f[4], 1.f - f[5], 1.f - f[6], 1.f - f[7]); }
    if (tid < 64) { float v4[4]; unpack4(gv, v4); *(float4*)(L + stv * STEP + 320 + ptv * 4) = make_float4(v4[0], v4[1], v4[2], v4[3]); }
  };
  f32x2_t s01 = {0.f, 0.f}, s23 = {0.f, 0.f};
  gload(0); lwrite(0);
  __syncthreads();
  f32x4 qA[2][2], qB[2][2], qW[2][2], qK[2][2], qR[2][2]; float qv[2][2];
#define SLOAD(set, Lp, g) do { _Pragma("unroll") for (int _u = 0; _u < 2; ++_u) { const float* _Ls = (Lp) + ((g) * 2 + _u) * STEP; \
    qA[set][_u] = *(const f32x4*)(_Ls + 4 * c); qB[set][_u] = *(const f32x4*)(_Ls + 64 + 4 * c); qW[set][_u] = *(const f32x4*)(_Ls + 128 + 4 * c); \
    qK[set][_u] = *(const f32x4*)(_Ls + 192 + 4 * c); qR[set][_u] = *(const f32x4*)(_Ls + 256 + 4 * c); qv[set][_u] = _Ls[320 + rloc]; } } while (0)
#define SSTEP(set, u, stidx) do { \
    const f32x4 A = qA[set][u], Bv = qB[set][u], W = qW[set][u], Kv = qK[set][u], R = qR[set][u]; const float v = qv[set][u]; \
    const f32x2_t vv = {v, v}; \
    const f32x2_t A01 = {A[0], A[1]}, A23 = {A[2], A[3]}, B01 = {Bv[0], Bv[1]}, B23 = {Bv[2], Bv[3]}, W01 = {W[0], W[1]}, W23 = {W[2], W[3]}; \
    const f32x2_t K01 = {Kv[0], Kv[1]}, K23 = {Kv[2], Kv[3]}, R01 = {R[0], R[1]}, R23 = {R[2], R[3]}; \
    const f32x2_t pd2 = s01 * A01 + s23 * A23; \
    const f32x2_t t01 = s01 * W01 + vv * K01, t23 = s23 * W23 + vv * K23; \
    const float pdot = rowsum16(pd2[0] + pd2[1]); \
    const f32x2_t pp = {pdot, pdot}; \
    s01 = pp * B01 + t01; s23 = pp * B23 + t23; \
    const f32x2_t y2 = s01 * R01 + s23 * R23; \
    yp[stidx] = y2[0] + y2[1]; } while (0)
  for (int ch = 0; ch < 256; ++ch) {
    const float* L = lds + (ch & 1) * BUF;
    if (ch + 1 < 256) gload(ch + 1);
    float yp[16];
    SLOAD(0, L, 0);
#pragma unroll
    for (int g = 0; g < 8; g += 2) {
      SLOAD(1, L, g + 1);
      SSTEP(0, 0, g * 2); SSTEP(0, 1, g * 2 + 1);
      if (g + 2 < 8) SLOAD(0, L, g + 2);
      SSTEP(1, 0, g * 2 + 2); SSTEP(1, 1, g * 2 + 3);
    }
    float ykeep;
    {
      const bool m8 = (c & 8) != 0, m4 = (c & 4) != 0, m2 = (c & 2) != 0, m1 = (c & 1) != 0;
      float r8[8], r4[4], r2[2];
#pragma unroll
      for (int i = 0; i < 8; ++i) { const float keep = m8 ? yp[i + 8] : yp[i], send = m8 ? yp[i] : yp[i + 8]; r8[i] = keep + dppf<0x140>(send); }
#pragma unroll
      for (int i = 0; i < 4; ++i) { const float keep = m4 ? r8[i + 4] : r8[i], send = m4 ? r8[i] : r8[i + 4]; r4[i] = keep + dppf<0x141>(send); }
#pragma unroll
      for (int i = 0; i < 2; ++i) { const float keep = m2 ? r4[i + 2] : r4[i], send = m2 ? r4[i] : r4[i + 2]; r2[i] = keep + dppf<0x4E>(send); }
      { const float keep = m1 ? r2[1] : r2[0], send = m1 ? r2[0] : r2[1]; ykeep = keep + dppf<0xB1>(send); }
    }
    Y[base + (size_t)(ch * 16 + c) * 384 + row] = ykeep;
    if (ch + 1 < 256) lwrite((ch + 1) & 1);
    __syncthreads();
  }
#undef SLOAD
#undef SSTEP
}

__device__ void attn_task(const Params& p, int task) {
  const int lane = otid() & 63, r = lane & 31, hh = lane >> 5;
  const int bh = task >> 7, qt = 127 - (task & 127);
  const int b = bh / 6, h = bh - b * 6;
  const int t0 = qt * 32;
  const bf16_t* sbq = (const bf16_t*)(p.ws + OFF_SBQ); const bf16_t* sbk = (const bf16_t*)(p.ws + OFF_SBK); const bf16_t* sbvt = (const bf16_t*)(p.ws + OFF_SBVT);
  bf16x8 qf[4];
  {
    const bf16_t* qb = sbq + ((size_t)bh * 4096 + t0 + r) * 64 + 8 * hh;
#pragma unroll
    for (int ks = 0; ks < 4; ++ks) qf[ks] = *(const bf16x8*)(qb + 16 * ks);
  }
  f32x16 o0, o1;
#pragma unroll
  for (int i = 0; i < 16; ++i) { o0[i] = 0.f; o1[i] = 0.f; }
  float crun = 0.f;
  for (int kb = qt; kb >= 0; --kb) {
    const bf16_t* kp = sbk + ((size_t)bh * 4096 + kb * 32 + r) * 64 + 8 * hh;
    f32x16 s;
#pragma unroll
    for (int i = 0; i < 16; ++i) s[i] = 0.f;
#pragma unroll
    for (int ks = 0; ks < 4; ++ks) s = MFMA32(*(const bf16x8*)(kp + 16 * ks), qf[ks], s);
    const bool diag = (kb == qt);
    float C[16], tg[4], ptn[4], both[4], suf[4];
    bool cz[16];
#pragma unroll
    for (int g = 0; g < 4; ++g) {
      float run = 0.f;
#pragma unroll
      for (int i = 3; i >= 0; --i) {
        const int reg = 4 * g + i;
        const int key = i + 8 * g + 4 * hh;
        const bool causal = (!diag) || (key < r);
        cz[reg] = causal;
        const float L = causal ? -softplusf_(s[reg]) : 0.f;
        run += L;
        C[reg] = run;
      }
      tg[g] = run;
    }
#pragma unroll
    for (int g = 0; g < 4; ++g) { ptn[g] = __shfl_xor(tg[g], 32); both[g] = tg[g] + ptn[g]; }
    suf[3] = 0.f; suf[2] = both[3]; suf[1] = suf[2] + both[2]; suf[0] = suf[1] + both[1];
    float A[16];
#pragma unroll
    for (int g = 0; g < 4; ++g) {
      const float off = suf[g] + (hh == 0 ? ptn[g] : 0.f) + crun;
#pragma unroll
      for (int i = 0; i < 4; ++i) { const int reg = 4 * g + i; A[reg] = cz[reg] ? __expf(s[reg] + C[reg] + off) : 0.f; }
    }
    crun += suf[0] + both[0];
#pragma unroll
    for (int s2 = 0; s2 < 2; ++s2) {
      const bf16x8 pf = pack8(&A[8 * s2]);
      {
        const bf16_t* vp = sbvt + ((size_t)bh * 64 + r) * 4096 + kb * 32 + 16 * s2 + 4 * hh;
        const u32x2 lo = *(const u32x2*)vp, hi = *(const u32x2*)(vp + 8);
        u32x4 vv = {lo.x, lo.y, hi.x, hi.y};
        o0 = MFMA32(pf, *reinterpret_cast<bf16x8*>(&vv), o0);
      }
      {
        const bf16_t* vp = sbvt + ((size_t)bh * 64 + 32 + r) * 4096 + kb * 32 + 16 * s2 + 4 * hh;
        const u32x2 lo = *(const u32x2*)vp, hi = *(const u32x2*)(vp + 8);
        u32x4 vv = {lo.x, lo.y, hi.x, hi.y};
        o1 = MFMA32(pf, *reinterpret_cast<bf16x8*>(&vv), o1);
      }
    }
    if (__ballot(crun >= -110.f) == 0ull) break;
  }
  bf16_t* mix = (bf16_t*)(p.ws + OFF_HBUF);
#pragma unroll
  for (int reg = 0; reg < 16; ++reg) {
    const int q = (reg & 3) + 8 * (reg >> 2) + 4 * hh;
    bf16_t* d = mix + ((size_t)b * 4096 + t0 + q) * 1024 + 384 + h * 64 + r;
    d[0] = f2bf(o0[reg]); d[32] = f2bf(o1[reg]);
  }
}

__device__ void post_phase(const Params& p, int l, int gt, int nt) {
  const float* Y = (const float*)(p.ws + OFF_PROJR); const bf16_t* SV = (const bf16_t*)(p.ws + OFF_SV); const bf16_t* Gp = (const bf16_t*)(p.ws + OFF_G);
  const float* bonus = (const float*)(p.ws + OFF_BONUS);
  bf16_t* mix = (bf16_t*)(p.ws + OFF_HBUF);
  const int total = M_ * 96;
  for (int i = gt; i < total; i += nt) {
    const int tok = i / 96, cgp = i - tok * 96, c = cgp * 4, h = cgp >> 4;
    const size_t o = (size_t)tok * 384 + c;
    const float4 y = *(const float4*)(Y + o);
    float v4[4], g4[4]; unpack4(*(const u32x2*)(SV + o), v4); unpack4(*(const u32x2*)(Gp + o), g4);
    const float mean = rowsum16((y.x + y.y) + (y.z + y.w)) * (1.f / 64.f);
    const float d0 = y.x - mean, d1 = y.y - mean, d2 = y.z - mean, d3 = y.w - mean;
    const float var = rowsum16((d0 * d0 + d1 * d1) + (d2 * d2 + d3 * d3)) * (1.f / 64.f);
    const float rs = rsqrtf(var + 64e-5f);
    const float4 lw = *(const float4*)(p.lnx_w + l * 384 + c), lb = *(const float4*)(p.lnx_b + l * 384 + c);
    const float bo = bonus[(size_t)tok * 6 + h];
    *(u32x2*)(mix + (size_t)tok * 1024 + c) = pack4((d0 * rs * lw.x + lb.x + bo * v4[0]) * g4[0], (d1 * rs * lw.y + lb.y + bo * v4[1]) * g4[1],
                                                    (d2 * rs * lw.z + lb.z + bo * v4[2]) * g4[2], (d3 * rs * lw.w + lb.w + bo * v4[3]) * g4[3]);
  }
}

__global__ void __launch_bounds__(256, 2) fwd_megakernel(Params p) {
  __shared__ __attribute__((aligned(16))) unsigned char smem[65536];
  GridBar gb; gb.bar = (unsigned*)(p.ws + OFF_BAR); gb.nloc = 0u; gb.nx = 0u;
  gb.x = (unsigned)__builtin_amdgcn_s_getreg((3 << 11) | 20) & 0xFu;
  if (threadIdx.x == 0) (void)xb_add(&gb.bar[XB_XCNT(gb.x)], 1u);
  const int bid = blockIdx.x, G = gridDim.x;
#define wave (otid() >> 6)
#define gw (bid * 4 + (otid() >> 6))
#define gt (bid * 256 + otid())
  const int vb = (bid & 7) * (G >> 3) + (bid >> 3);
  const int nw = G * 4, ngt = G * 256;
  bf16_t* hbuf = (bf16_t*)(p.ws + OFF_HBUF);

  prep_phase(p, 0, vb, G, gt, ngt, smem);
  norm_phase(p.x, p.ln1_g, hbuf, gw, nw);
  grid_barrier(gb);
#pragma unroll 1
  for (int l = 0; l < 2; ++l) {
    if (l > 0) { norm_phase(p.out, p.ln1_g + 1024, hbuf, gw, nw); grid_barrier(gb); }
    gemm_phase<0>(p, l, vb, G, smem);
    grid_barrier(gb);
    for (int blk = bid; blk < 512; blk += G) rwkv_prep_task(p, l, (blk * 4 + wave) * 16, smem);
    grid_barrier(gb);
    if (bid < 192) scan_block(p, bid, smem);
    else {
      for (int task = (bid - 192) * 4 + wave; task < 6144; task += (G - 192) * 4) attn_task(p, task);
      for (int task = (bid - 192) * 4 + wave; task < 2048; task += (G - 192) * 4) pool_task(p, l, task * 16);
      if (l == 0) { __syncthreads(); prep_phase(p, 1, bid - 192, G - 192, (bid - 192) * 256 + otid(), (G - 192) * 256, smem); }
    }
    grid_barrier(gb);
    post_phase(p, l, gt, ngt);
    grid_barrier(gb);
    gemm_phase<1>(p, l, vb, G, smem);
    grid_barrier(gb);
    norm_phase(p.out, p.ln2_g + l * 1024, hbuf, gw, nw);
    grid_barrier(gb);
    gemm_phase<2>(p, l, vb, G, smem);
    grid_barrier(gb);
    gemm_phase<3>(p, l, vb, G, smem);
    if (l == 0) grid_barrier(gb);
  }
}

#undef wave
#undef gw
#undef gt

extern "C" void kernel_launch(void* const* d_in, const int* in_sizes, int n_in, void* d_out, int out_size, void* d_ws, size_t ws_size, hipStream_t stream) {
  static int grid_blocks = 0;
  if (!grid_blocks) {
    int dev = 0, cus = 0, per_cu = 0;
    (void)hipGetDevice(&dev);
    (void)hipDeviceGetAttribute(&cus, hipDeviceAttributeMultiprocessorCount, dev);
    (void)hipOccupancyMaxActiveBlocksPerMultiprocessor(&per_cu, fwd_megakernel, 256, 0);
    if (per_cu > 2) per_cu = 2;
    if (per_cu < 1) per_cu = 1;
    if (cus <= 0) cus = 256;
    grid_blocks = cus * per_cu;
    grid_blocks &= ~7;
  }
  Params p{};
  p.x = (const float*)d_in[0]; p.ln1_g = (const float*)d_in[1]; p.w_in = (const float*)d_in[2]; p.mu = (const float*)d_in[3]; p.w0 = (const float*)d_in[4];
  p.w2 = (const float*)d_in[5]; p.a0 = (const float*)d_in[6]; p.a2 = (const float*)d_in[7]; p.g2 = (const float*)d_in[8]; p.k_k = (const float*)d_in[9];
  p.k_a = (const float*)d_in[10]; p.r_k = (const float*)d_in[11]; p.lnx_w = (const float*)d_in[12]; p.lnx_b = (const float*)d_in[13]; p.v0 = (const float*)d_in[14];
  p.v1 = (const float*)d_in[15]; p.v2 = (const float*)d_in[16]; p.q_gain = (const float*)d_in[17]; p.k_gain = (const float*)d_in[18]; p.pool_w = (const float*)d_in[19];
  p.pool_b = (const float*)d_in[20]; p.pool_scale = (const float*)d_in[21]; p.w_out = (const float*)d_in[22]; p.ln2_g = (const float*)d_in[23];
  p.w_up = (const float*)d_in[24]; p.conv_w = (const float*)d_in[25]; p.conv_b = (const float*)d_in[26]; p.w_down = (const float*)d_in[27];
  p.out = (float*)d_out; p.ws = (unsigned char*)d_ws;
  (void)hipMemsetAsync(d_ws, 0, XB_BYTES, stream);
  void* args[] = {&p};
  hipError_t e = hipLaunchCooperativeKernel((const void*)fwd_megakernel, dim3(grid_blocks), dim3(256), args, 0, stream);
  if (e != hipSuccess) fprintf(stderr, "cooperative launch failed: %s (grid %d)\n", hipGetErrorString(e), grid_blocks);
}
```

```cpp
#include <hip/hip_runtime.h>
#include <stdint.h>
#include <cstdio>

typedef unsigned short bf16_t;
typedef short bf16x8 __attribute__((ext_vector_type(8)));
typedef float f32x4 __attribute__((ext_vector_type(4)));
typedef float f32x16 __attribute__((ext_vector_type(16)));
typedef unsigned u32x4 __attribute__((ext_vector_type(4)));
typedef unsigned u32x2 __attribute__((ext_vector_type(2)));

#define TID ((int)threadIdx.x)
__device__ __forceinline__ int otid() { int t = threadIdx.x; asm volatile("" : "+v"(t)); return t; }
constexpr int T_ = 4096, M_ = 32768;
constexpr size_t MiB = 1u << 20;
constexpr size_t OFF_BAR = 0;
constexpr size_t OFF_BONUS = 1 * MiB;
constexpr size_t OFF_SMALLW = 2 * MiB;
constexpr size_t OFF_WB = 3 * MiB;
constexpr size_t OFF_VFIRST = 51 * MiB;
constexpr size_t OFF_HBUF = 75 * MiB;
constexpr size_t OFF_G = 139 * MiB;
constexpr size_t OFF_SW = 163 * MiB;
constexpr size_t OFF_SR = 211 * MiB;
constexpr size_t OFF_SK = 235 * MiB;
constexpr size_t OFF_SV = 259 * MiB;
constexpr size_t OFF_SA = 283 * MiB;
constexpr size_t OFF_SB = 307 * MiB;
constexpr size_t OFF_PROJR = 331 * MiB;
constexpr size_t OFF_SBQ = 419 * MiB;
constexpr size_t OFF_SBK = 443 * MiB;
constexpr size_t OFF_SBVT = 467 * MiB;
constexpr size_t OFF_POOL = 491 * MiB;
constexpr size_t OFF_ACT = 163 * MiB;
constexpr size_t WB_LAYER = 12582912;
constexpr size_t WB_IN = 0, WB_OUT = 2883584, WB_UP = 3932160, WB_DOWN = 9699328;
constexpr size_t SW_LAYER = 139264;
constexpr size_t SW_W2 = 0, SW_A2 = 24576, SW_G2 = 49152, SW_POOL = 98304, SW_V1 = 114688, SW_V2 = 126976;

struct Params {
  const float* x; const float* ln1_g; const float* w_in; const float* mu; const float* w0; const float* w2; const float* a0; const float* a2; const float* g2;
  const float* k_k; const float* k_a; const float* r_k; const float* lnx_w; const float* lnx_b; const float* v0; const float* v1; const float* v2;
  const float* q_gain; const float* k_gain; const float* pool_w; const float* pool_b; const float* pool_scale; const float* w_out; const float* ln2_g;
  const float* w_up; const float* conv_w; const float* conv_b; const float* w_down;
  float* out; unsigned char* ws;
};

typedef __bf16 bf16x2_t __attribute__((ext_vector_type(2)));
typedef float f32x2_t __attribute__((ext_vector_type(2)));
__device__ __forceinline__ unsigned pk_bf16(float lo, float hi) { f32x2_t f = {lo, hi}; bf16x2_t b = __builtin_convertvector(f, bf16x2_t); return *reinterpret_cast<unsigned*>(&b); }
__device__ __forceinline__ float bf_lo(unsigned u) { return __uint_as_float(u << 16); }
__device__ __forceinline__ float bf_hi(unsigned u) { return __uint_as_float(u & 0xffff0000u); }
__device__ __forceinline__ bf16_t f2bf(float f) { return (bf16_t)(pk_bf16(f, 0.f) & 0xffffu); }
__device__ __forceinline__ bf16x8 pack8(const float* f) { u32x4 w = {pk_bf16(f[0], f[1]), pk_bf16(f[2], f[3]), pk_bf16(f[4], f[5]), pk_bf16(f[6], f[7])}; return *reinterpret_cast<bf16x8*>(&w); }
__device__ __forceinline__ void unpack8(u32x4 u, float* f) { f[0] = bf_lo(u.x); f[1] = bf_hi(u.x); f[2] = bf_lo(u.y); f[3] = bf_hi(u.y); f[4] = bf_lo(u.z); f[5] = bf_hi(u.z); f[6] = bf_lo(u.w); f[7] = bf_hi(u.w); }
__device__ __forceinline__ void unpack4(u32x2 u, float* f) { f[0] = bf_lo(u.x); f[1] = bf_hi(u.x); f[2] = bf_lo(u.y); f[3] = bf_hi(u.y); }
__device__ __forceinline__ u32x2 pack4(float a, float b, float c, float d) { u32x2 r = {pk_bf16(a, b), pk_bf16(c, d)}; return r; }
__device__ __forceinline__ float sigmoidf_(float x) { return __builtin_amdgcn_rcpf(1.f + __expf(-x)); }
__device__ __forceinline__ float softplusf_(float x) { return fmaxf(x, 0.f) + 0.69314718f * __builtin_amdgcn_logf(1.f + __expf(-fabsf(x))); }
__device__ __forceinline__ float tanhf_(float x) { float e = __expf(2.f * x); return 1.f - 2.f * __builtin_amdgcn_rcpf(e + 1.f); }
#define MFMA16(a, b, c) __builtin_amdgcn_mfma_f32_16x16x32_bf16((a), (b), (c), 0, 0, 0)
#define MFMA32(a, b, c) __builtin_amdgcn_mfma_f32_32x32x16_bf16((a), (b), (c), 0, 0, 0)

template <int CTRL> __device__ __forceinline__ float dppf(float x) { return __int_as_float(__builtin_amdgcn_update_dpp(0, __float_as_int(x), CTRL, 0xf, 0xf, true)); }
__device__ __forceinline__ float rowsum16(float x) {
  x += dppf<0xB1>(x);
  x += dppf<0x4E>(x);
  x += dppf<0x141>(x);
  x += dppf<0x140>(x);
  return x;
}
__device__ __forceinline__ float wavesum(float x) {
#pragma unroll
  for (int o = 32; o >= 1; o >>= 1) x += __shfl_xor(x, o);
  return x;
}

#define XB_XCNT(j) (64 * (1 + (j)))
#define XB_XSUB(j) (64 * (17 + (j)))
#define XB_XGEN(j) (64 * (33 + (j)))
#define XB_TOP (64 * 49)
#define XB_TOPGEN (64 * 50)
#define XB_BYTES (64 * 51 * 4)
__device__ __forceinline__ unsigned xb_ld(unsigned* p) { return __hip_atomic_load(p, __ATOMIC_RELAXED, __HIP_MEMORY_SCOPE_AGENT); }
__device__ __forceinline__ unsigned xb_add(unsigned* p, unsigned v) { return __hip_atomic_fetch_add(p, v, __ATOMIC_RELAXED, __HIP_MEMORY_SCOPE_AGENT); }
struct GridBar { unsigned* bar; unsigned x, nloc, nx; };
__device__ __forceinline__ void grid_barrier(GridBar& gb) {
  asm volatile("s_waitcnt vmcnt(0) lgkmcnt(0)" ::: "memory");
  __syncthreads();
  if (threadIdx.x == 0) {
    unsigned* bar = gb.bar;
    if (gb.nloc == 0u) {
      const unsigned G = gridDim.x;
      unsigned sum, cnt, mine;
      for (;;) {
        sum = 0u; cnt = 0u; mine = 0u;
#pragma unroll
        for (unsigned j = 0; j < 16; ++j) { const unsigned cc = xb_ld(&bar[XB_XCNT(j)]); sum += cc; cnt += (cc > 0u) ? 1u : 0u; mine = (j == gb.x) ? cc : mine; }
        if (sum == G) break;
        __builtin_amdgcn_s_sleep(1);
      }
      gb.nloc = mine; gb.nx = cnt;
    }
    const unsigned old = xb_add(&bar[XB_XSUB(gb.x)], 1u);
    const unsigned gen = old / gb.nloc;
    if (old + 1u == (gen + 1u) * gb.nloc) {
      __builtin_amdgcn_fence(__ATOMIC_RELEASE, "agent");
      asm volatile("s_waitcnt vmcnt(0)" ::: "memory");
      const unsigned og = xb_add(&bar[XB_TOP], 1u);
      const unsigned tg = og / gb.nx;
      if (og + 1u == (tg + 1u) * gb.nx) xb_add(&bar[XB_TOPGEN], 1u);
      else { while (xb_ld(&bar[XB_TOPGEN]) == tg) __builtin_amdgcn_s_sleep(1); }
      __builtin_amdgcn_fence(__ATOMIC_ACQUIRE, "agent");
      xb_add(&bar[XB_XGEN(gb.x)], 1u);
      asm volatile("s_waitcnt vmcnt(0)" ::: "memory");
    } else {
      while (xb_ld(&bar[XB_XGEN(gb.x)]) == gen) __builtin_amdgcn_s_sleep(1);
      __builtin_amdgcn_fence(__ATOMIC_ACQUIRE, "agent");
      asm volatile("s_waitcnt vmcnt(0)" ::: "memory");
    }
  }
  __syncthreads();
}

template <int PERM>
__device__ void transpose_big(const float* __restrict__ src, int K, int N, int Ndst, bf16_t* dst, int vb, int G, unsigned char* smem) {
  float* tile = (float*)smem;
  const int nkt = K >> 6, nnt = Ndst >> 6, ntile = nkt * nnt;
  const int tid_ = otid(); const int tl = tid_ & 63, th = tid_ >> 6;
  for (int tt = vb; tt < ntile; tt += G) {
    const int kt = tt % nkt, nt = tt / nkt;
    const int k0 = kt << 6, n0 = nt << 6;
    int sc;
    if (PERM == 0) sc = n0 + tl; else sc = (tl < 32) ? (nt * 32 + tl) : (2816 + nt * 32 + tl - 32);
#pragma unroll
    for (int i = 0; i < 16; ++i) { const int kk = i * 4 + th; tile[kk * 65 + tl] = src[(size_t)(k0 + kk) * N + sc]; }
    __syncthreads();
#pragma unroll
    for (int i = 0; i < 16; ++i) { const int nn = i * 4 + th; dst[(size_t)(n0 + nn) * K + k0 + tl] = f2bf(tile[tl * 65 + nn]); }
    __syncthreads();
  }
}
__device__ void transpose_small(const float* __restrict__ src, int K, int N, bf16_t* dst, int gt, int nt) {
  const int tot = K * N;
  for (int i = gt; i < tot; i += nt) { const int n = i / K, k = i - n * K; dst[i] = f2bf(src[(size_t)k * N + n]); }
}

__device__ void prep_phase(const Params& p, int part, int vb, int G, int gt, int nt, unsigned char* smem) {
  bf16_t* wb = (bf16_t*)(p.ws + OFF_WB);
  bf16_t* sw = (bf16_t*)(p.ws + OFF_SMALLW);
  for (int l = 0; l < 2; ++l) {
    bf16_t* w = wb + (size_t)l * WB_LAYER;
    const bool first = (l == 0);
    if ((part == 0) == first) {
      transpose_big<0>(p.w_in + (size_t)l * 1024 * 2816, 1024, 2816, 2816, w + WB_IN, vb, G, smem);
      bf16_t* s = sw + (size_t)l * SW_LAYER;
      transpose_small(p.w2 + (size_t)l * 64 * 384, 64, 384, s + SW_W2, gt, nt);
      transpose_small(p.a2 + (size_t)l * 64 * 384, 64, 384, s + SW_A2, gt, nt);
      transpose_small(p.g2 + (size_t)l * 128 * 384, 128, 384, s + SW_G2, gt, nt);
      for (int g = 0; g < 4; ++g) transpose_small(p.pool_w + (size_t)(l * 4 + g) * 4096, 64, 64, s + SW_POOL + g * 4096, gt, nt);
      if (l == 1) {
        transpose_small(p.v1, 384, 32, s + SW_V1, gt, nt);
        transpose_small(p.v2, 32, 384, s + SW_V2, gt, nt);
      }
    }
    if (part == 1) {
      transpose_big<0>(p.w_out + (size_t)l * 1024 * 1024, 1024, 1024, 1024, w + WB_OUT, vb, G, smem);
      transpose_big<1>(p.w_up + (size_t)l * 1024 * 5632, 1024, 5632, 5632, w + WB_UP, vb, G, smem);
      transpose_big<0>(p.w_down + (size_t)l * 2816 * 1024, 2816, 1024, 1024, w + WB_DOWN, vb, G, smem);
    }
  }
}

__device__ void norm_phase(const float* x, const float* __restrict__ g, bf16_t* h, int gw, int nw) {
  const int lane = otid() & 63;
  for (int row = gw; row < M_; row += nw) {
    const float4* xr = (const float4*)(x + (size_t)row * 1024);
    float4 v[4]; float ss = 0.f;
#pragma unroll
    for (int i = 0; i < 4; ++i) { { const f32x4 t_ = __builtin_nontemporal_load((const f32x4*)&xr[lane + 64 * i]); v[i] = make_float4(t_[0], t_[1], t_[2], t_[3]); } ss += v[i].x * v[i].x + v[i].y * v[i].y + v[i].z * v[i].z + v[i].w * v[i].w; }
    ss = wavesum(ss);
    const float rs = rsqrtf(ss * (1.f / 1024.f) + 1e-6f);
#pragma unroll
    for (int i = 0; i < 4; ++i) {
      const float4 gv = ((const float4*)g)[lane + 64 * i];
      *(u32x2*)(h + (size_t)row * 1024 + (lane + 64 * i) * 4) = pack4(v[i].x * rs * gv.x, v[i].y * rs * gv.y, v[i].z * rs * gv.z, v[i].w * rs * gv.w);
    }
  }
}

#define LAS __attribute__((address_space(3)))
__device__ __forceinline__ void stage_rc(int b, int& R, int& C) {
  R = b >> 7; C = (((b >> 4) & 7) ^ (R & 7)) * 8;
}
#define GSTAGE(A_, W_, ao_, wo_, buf, kt) do { const int _wb = __builtin_amdgcn_readfirstlane(tid >> 6) * 1024; _Pragma("unroll") for (int _i = 0; _i < 4; ++_i) { \
    __builtin_amdgcn_global_load_lds((const unsigned*)((A_) + (ao_)[_i] + (kt) * 64), (LAS unsigned*)((LAS unsigned char*)smem + (buf) * 32768 + _wb + _i * 4096), 16, 0, 0); \
    __builtin_amdgcn_global_load_lds((const unsigned*)((W_) + (wo_)[_i] + (kt) * 64), (LAS unsigned*)((LAS unsigned char*)smem + (buf) * 32768 + 16384 + _wb + _i * 4096), 16, 0, 0); } } while (0)
__device__ __forceinline__ void gemm_mainloop(const bf16_t* A, const bf16_t* W, const unsigned (&ao)[4], const unsigned (&wo)[4], int nk, unsigned char* smem, f32x4 (&acc)[4][4]) {
  const int tid = otid(), lane = tid & 63, wave = tid >> 6, wr = wave >> 1, wc = wave & 1, fr = lane & 15, fq = lane >> 4;
  const int foff0 = fr * 128 + ((fq ^ (fr & 7)) << 4), foff1 = fr * 128 + (((4 + fq) ^ (fr & 7)) << 4);
  const int aoff = (wr * 64) * 128, boff = 16384 + (wc * 64) * 128;
  asm volatile("s_waitcnt vmcnt(0)" ::: "memory");
  __syncthreads();
  for (int kt = 0; kt < nk; ++kt) {
    const int cb = kt & 1;
    unsigned char* cur = smem + cb * 32768;
    bf16x8 af[2][4], wf[2][4];
#pragma unroll
    for (int ks = 0; ks < 2; ++ks) {
#pragma unroll
      for (int mt = 0; mt < 4; ++mt) af[ks][mt] = *(const bf16x8*)(cur + aoff + mt * 2048 + (ks ? foff1 : foff0));
#pragma unroll
      for (int nt = 0; nt < 4; ++nt) wf[ks][nt] = *(const bf16x8*)(cur + boff + nt * 2048 + (ks ? foff1 : foff0));
    }
    __builtin_amdgcn_sched_barrier(0);
    if (kt + 1 < nk) GSTAGE(A, W, ao, wo, cb ^ 1, kt + 1);
#pragma unroll
    for (int ks = 0; ks < 2; ++ks) {
#pragma unroll
      for (int nt = 0; nt < 4; ++nt)
#pragma unroll
        for (int mt = 0; mt < 4; ++mt) acc[nt][mt] = MFMA16(wf[ks][nt], af[ks][mt], acc[nt][mt]);
    }
    __builtin_amdgcn_sched_barrier(0);
    asm volatile("s_waitcnt vmcnt(0)" ::: "memory");
    __syncthreads();
  }
}

template <int MODE>
__device__ void gemm_phase(const Params& p, int l, int vb, int G, unsigned char* smem) {
  const int tid = otid(), lane = tid & 63, wave = tid >> 6, wr = wave >> 1, wc = wave & 1, fr = lane & 15, fq = lane >> 4;
  const bf16_t* wbl = (const bf16_t*)(p.ws + OFF_WB) + (size_t)l * WB_LAYER;
  const bf16_t* A; const bf16_t* W; int K, nN, nM, lda;
  if (MODE == 0) { A = (const bf16_t*)(p.ws + OFF_HBUF); W = wbl + WB_IN; K = 1024; nN = 22; nM = 256; lda = 1024; }
  if (MODE == 1) { A = (const bf16_t*)(p.ws + OFF_HBUF); W = wbl + WB_OUT; K = 1024; nN = 8; nM = 256; lda = 1024; }
  if (MODE == 2) { A = (const bf16_t*)(p.ws + OFF_HBUF); W = wbl + WB_UP; K = 1024; nN = 44; nM = 264; lda = 1024; }
  if (MODE == 3) { A = (const bf16_t*)(p.ws + OFF_ACT); W = wbl + WB_DOWN; K = 2816; nN = 8; nM = 256; lda = 2816; }
  const int ntile = nM * nN, nk = K >> 6;
  auto tile_pmn = [&](int tile, int& pm_, int& pn_) { const int grp = tile / (8 * nN), within = tile - grp * (8 * nN); pm_ = grp * 8 + (within & 7); pn_ = within >> 3; };
  auto tile_offs = [&](int pm_, int pn_, unsigned (&ao_)[4], unsigned (&wo_)[4]) {
    int tb_ = 0, ti_ = 0;
    if (MODE == 2) { tb_ = pm_ / 33; ti_ = pm_ - tb_ * 33; }
#pragma unroll
    for (int i = 0; i < 4; ++i) {
      int r, cc; stage_rc(tid * 16 + i * 4096, r, cc);
      unsigned grow;
      if (MODE == 2) { int t = 126 * ti_ - 2 + r; t = t < 0 ? 0 : (t > 4095 ? 4095 : t); grow = (unsigned)(tb_ * 4096 + t); }
      else grow = (unsigned)(pm_ * 128 + r);
      ao_[i] = grow * (unsigned)lda + (unsigned)cc;
      wo_[i] = (unsigned)(pn_ * 128 + r) * (unsigned)K + (unsigned)cc;
    }
  };
  unsigned ao[4], wo[4];
  int pm = 0, pn = 0;
  if (vb < ntile) { tile_pmn(vb, pm, pn); tile_offs(pm, pn, ao, wo); GSTAGE(A, W, ao, wo, 0, 0); }
  for (int tile = vb; tile < ntile; tile += G) {
    const int n0 = pn * 128;
    int tb = 0, ti = 0;
    if (MODE == 2) { tb = pm / 33; ti = pm - tb * 33; }
    f32x4 acc[4][4];
#pragma unroll
    for (int a = 0; a < 4; ++a)
#pragma unroll
      for (int b = 0; b < 4; ++b) acc[a][b] = (f32x4){0.f, 0.f, 0.f, 0.f};
    gemm_mainloop(A, W, ao, wo, nk, smem, acc);
    const int cpm = pm; (void)cpm;
    int npm = 0, npn = 0;
    const bool has_next = (tile + G) < ntile;
    if (has_next) { tile_pmn(tile + G, npm, npn); tile_offs(npm, npn, ao, wo); }
    if (MODE != 2) { if (has_next) GSTAGE(A, W, ao, wo, 0, 0); }

    if (MODE == 0) {
      const int cg = (n0 + wc * 64) >> 6;
#pragma unroll
      for (int mt = 0; mt < 4; ++mt) {
        const int tok = pm * 128 + wr * 64 + mt * 16 + fr;
        const int b = tok >> 12, t = tok & 4095;
        if (cg < 22) {
          bf16_t* d = (bf16_t*)(p.ws + OFF_PROJR) + (size_t)tok * 1408 + cg * 64 + fq * 4;
#pragma unroll
          for (int nt = 0; nt < 4; ++nt) *(u32x2*)(d + nt * 16) = pack4(acc[nt][mt][0], acc[nt][mt][1], acc[nt][mt][2], acc[nt][mt][3]);
        } else if (cg < 34) {
          const bool isq = cg < 28; const int head = isq ? cg - 22 : cg - 28;
          const float* gain = (isq ? p.q_gain : p.k_gain) + l * 64;
          float ss = 0.f;
#pragma unroll
          for (int nt = 0; nt < 4; ++nt)
#pragma unroll
            for (int j = 0; j < 4; ++j) ss += acc[nt][mt][j] * acc[nt][mt][j];
          ss += __shfl_xor(ss, 16); ss += __shfl_xor(ss, 32);
          const float rs = rsqrtf(ss * (1.f / 64.f) + 1e-6f) * (isq ? 0.125f : 1.f);
          bf16_t* d = (bf16_t*)(p.ws + (isq ? OFF_SBQ : OFF_SBK)) + ((size_t)(b * 6 + head) * 4096 + t) * 64 + fq * 4;
#pragma unroll
          for (int nt = 0; nt < 4; ++nt) {
            const float4 gv = *(const float4*)(gain + nt * 16 + fq * 4);
            *(u32x2*)(d + nt * 16) = pack4(acc[nt][mt][0] * rs * gv.x, acc[nt][mt][1] * rs * gv.y, acc[nt][mt][2] * rs * gv.z, acc[nt][mt][3] * rs * gv.w);
          }
        } else if (cg < 40) {
          const int head = cg - 34;
          bf16_t* d = (bf16_t*)(p.ws + OFF_SBVT) + ((size_t)(b * 6 + head) * 64 + fq * 4) * 4096 + t;
#pragma unroll
          for (int nt = 0; nt < 4; ++nt)
#pragma unroll
            for (int j = 0; j < 4; ++j) d[(size_t)(nt * 16 + j) * 4096] = f2bf(acc[nt][mt][j]);
        } else {
          bf16_t* d = (bf16_t*)(p.ws + OFF_POOL) + (size_t)tok * 256 + (cg - 40) * 64 + fq * 4;
#pragma unroll
          for (int nt = 0; nt < 4; ++nt) *(u32x2*)(d + nt * 16) = pack4(acc[nt][mt][0], acc[nt][mt][1], acc[nt][mt][2], acc[nt][mt][3]);
        }
      }
    }
    if (MODE == 1 || MODE == 3) {
      const float* resid = (MODE == 1 && l == 0) ? p.x : p.out;
#pragma unroll
      for (int mh = 0; mh < 2; ++mh) {
        float4 rv[2][4];
#pragma unroll
        for (int m2 = 0; m2 < 2; ++m2) {
          const size_t tok = (size_t)pm * 128 + wr * 64 + (mh * 2 + m2) * 16 + fr;
#pragma unroll
          for (int nt = 0; nt < 4; ++nt) { const f32x4 t_ = __builtin_nontemporal_load((const f32x4*)(resid + tok * 1024 + n0 + wc * 64 + nt * 16 + fq * 4)); rv[m2][nt] = make_float4(t_[0], t_[1], t_[2], t_[3]); }
        }
#pragma unroll
        for (int m2 = 0; m2 < 2; ++m2) {
          const int mt = mh * 2 + m2;
          const size_t tok = (size_t)pm * 128 + wr * 64 + mt * 16 + fr;
#pragma unroll
          for (int nt = 0; nt < 4; ++nt) {
            float4 ov; ov.x = rv[m2][nt].x + acc[nt][mt][0]; ov.y = rv[m2][nt].y + acc[nt][mt][1]; ov.z = rv[m2][nt].z + acc[nt][mt][2]; ov.w = rv[m2][nt].w + acc[nt][mt][3];
            *(float4*)(p.out + tok * 1024 + n0 + wc * 64 + nt * 16 + fq * 4) = ov;
          }
        }
      }
    }
    if (MODE == 2) {
      float* halo = (float*)(smem + 32768);
      if (ti == 0 && wr == 0 && fr < 2) {
#pragma unroll
        for (int nt = 0; nt < 4; ++nt) acc[nt][0] = (f32x4){0.f, 0.f, 0.f, 0.f};
      }
      if (wr == 0 && fr >= 14) {
#pragma unroll
        for (int nt = 0; nt < 4; ++nt) *(f32x4*)(halo + (wc * 2 + (fr - 14)) * 64 + nt * 16 + fq * 4) = acc[nt][3];
      }
      __syncthreads();
      f32x4 xm1[4];
#pragma unroll
      for (int nt = 0; nt < 4; ++nt) {
        xm1[nt] = (f32x4){0.f, 0.f, 0.f, 0.f};
        if (wr == 1 && fr >= 14) xm1[nt] = *(const f32x4*)(halo + (wc * 2 + (fr - 14)) * 64 + nt * 16 + fq * 4);
      }
      __syncthreads();
      if (has_next) GSTAGE(A, W, ao, wo, 0, 0);
      const int Gc = (n0 + wc * 64) >> 6;
      const float* cw = p.conv_w + (size_t)l * 3 * 5632;
      const float* cb = p.conv_b + (size_t)l * 5632;
      bf16_t* actp = (bf16_t*)(p.ws + OFF_ACT);
#pragma unroll
      for (int nt = 0; nt < 2; ++nt) {
        const int ch = 32 * Gc + nt * 16 + fq * 4;
        const float4 cbg = *(const float4*)(cb + ch), cbv = *(const float4*)(cb + 2816 + ch);
        float4 cwg[3], cwv[3];
#pragma unroll
        for (int i = 0; i < 3; ++i) { cwg[i] = *(const float4*)(cw + i * 5632 + ch); cwv[i] = *(const float4*)(cw + i * 5632 + 2816 + ch); }
#pragma unroll
        for (int mt = 0; mt < 4; ++mt) {
          const int rt = wr * 64 + mt * 16 + fr;
          const int t = 126 * ti - 2 + rt;
          const bool valid = (rt >= 2) && (t < 4096);
          float o[4];
#pragma unroll
          for (int j = 0; j < 4; ++j) {
            float cvv[2];
#pragma unroll
            for (int gvi = 0; gvi < 2; ++gvi) {
              const int n2 = nt + 2 * gvi;
              const float x0 = acc[n2][mt][j];
              const float xp = (mt == 0) ? xm1[n2][j] : acc[n2][mt == 0 ? 0 : mt - 1][j];
              const float p1 = dppf<0x121>((fr == 15) ? xp : x0);
              const float p2 = dppf<0x122>((fr >= 14) ? xp : x0);
              const float4* wv = gvi ? cwv : cwg;
              const float bias = gvi ? ((const float*)&cbv)[j] : ((const float*)&cbg)[j];
              cvv[gvi] = bias + ((const float*)&wv[0])[j] * p2 + ((const float*)&wv[1])[j] * p1 + ((const float*)&wv[2])[j] * x0;
            }
            o[j] = cvv[0] * sigmoidf_(cvv[0]) * cvv[1];
          }
          if (valid) *(u32x2*)(actp + ((size_t)tb * 4096 + t) * 2816 + ch) = pack4(o[0], o[1], o[2], o[3]);
        }
      }
    }
    pm = npm; pn = npn;
  }
#undef GSTAGE
}

__device__ void rwkv_prep_task(const Params& p, int l, int tok0, unsigned char* smem) {
  const int lane = otid() & 63, fr = lane & 15, fq = lane >> 4;
  const int tok = tok0 + fr, t = tok & 4095;
  const bool hasprev = t > 0;
  const bf16_t* cur = (const bf16_t*)(p.ws + OFF_PROJR) + (size_t)tok * 1408;
  const bf16_t* prv = cur - (hasprev ? 1408 : 0);
  const float* mu = p.mu + l * 1408;
  const bf16_t* sw = (const bf16_t*)(p.ws + OFF_SMALLW) + (size_t)l * SW_LAYER;
  auto shift8 = [&](int c, float* o) {
    u32x4 uc = *(const u32x4*)(cur + c); u32x4 up = *(const u32x4*)(prv + c);
    float fc[8], fp[8]; unpack8(uc, fc); unpack8(up, fp);
    const float4 m0 = *(const float4*)(mu + c), m1 = *(const float4*)(mu + c + 4);
    const float m[8] = {m0.x, m0.y, m0.z, m0.w, m1.x, m1.y, m1.z, m1.w};
#pragma unroll
    for (int i = 0; i < 8; ++i) { const float pv = hasprev ? fp[i] : 0.f; o[i] = fc[i] + (pv - fc[i]) * m[i]; }
  };
  auto shift4 = [&](int c, float* o) {
    u32x2 uc = *(const u32x2*)(cur + c); u32x2 up = *(const u32x2*)(prv + c);
    float fc[4], fp[4]; unpack4(uc, fc); unpack4(up, fp);
    const float4 m0 = *(const float4*)(mu + c);
    const float m[4] = {m0.x, m0.y, m0.z, m0.w};
#pragma unroll
    for (int i = 0; i < 4; ++i) { const float pv = hasprev ? fp[i] : 0.f; o[i] = fc[i] + (pv - fc[i]) * m[i]; }
  };
  bf16x8 Bw[2], Ba[2], Bg[4], Bu;
  {
    float o[8];
#pragma unroll
    for (int ks = 0; ks < 2; ++ks) {
      shift8(1152 + ks * 32 + fq * 8, o);
#pragma unroll
      for (int i = 0; i < 8; ++i) o[i] = tanhf_(o[i]);
      Bw[ks] = pack8(o);
      shift8(1216 + ks * 32 + fq * 8, o);
      Ba[ks] = pack8(o);
    }
#pragma unroll
    for (int ks = 0; ks < 4; ++ks) {
      shift8(1280 + ks * 32 + fq * 8, o);
#pragma unroll
      for (int i = 0; i < 8; ++i) o[i] = sigmoidf_(o[i]);
      Bg[ks] = pack8(o);
    }
  }
  if (l == 1) {
    f32x4 u0 = {0.f, 0.f, 0.f, 0.f}, u1 = {0.f, 0.f, 0.f, 0.f};
    const bf16_t* v1t = sw + SW_V1;
#pragma unroll 2
    for (int ks = 0; ks < 12; ++ks) {
      float o[8]; shift8(768 + ks * 32 + fq * 8, o);
      const bf16x8 bv = pack8(o);
      const bf16x8 a0 = *(const bf16x8*)(v1t + (size_t)fr * 384 + ks * 32 + fq * 8);
      const bf16x8 a1 = *(const bf16x8*)(v1t + (size_t)(16 + fr) * 384 + ks * 32 + fq * 8);
      u0 = MFMA16(a0, bv, u0); u1 = MFMA16(a1, bv, u1);
    }
    const float uu[8] = {u0[0], u0[1], u0[2], u0[3], u1[0], u1[1], u1[2], u1[3]};
    Bu = pack8(uu);
  }
  const float* w0 = p.w0 + l * 384; const float* a0p = p.a0 + l * 384; const float* kkp = p.k_k + l * 384; const float* kap = p.k_a + l * 384;
  const float* rkp = p.r_k + l * 384; const float* v0p = p.v0;
  bf16_t* SR = (bf16_t*)(p.ws + OFF_SR); bf16_t* SK = (bf16_t*)(p.ws + OFF_SK); bf16_t* SV = (bf16_t*)(p.ws + OFF_SV);
  bf16_t* SA = (bf16_t*)(p.ws + OFF_SA); bf16_t* SBp = (bf16_t*)(p.ws + OFF_SB); bf16_t* Gp = (bf16_t*)(p.ws + OFF_G);
  bf16_t* VF = (bf16_t*)(p.ws + OFF_VFIRST); bf16_t* SWp = (bf16_t*)(p.ws + OFF_SW); float* bonus = (float*)(p.ws + OFF_BONUS);
  const int stid = otid();
#pragma unroll 1
  for (int h = 0; h < 6; ++h) {
    __syncthreads();
    {
      u32x4 t0, t1, t2, t3;
      { const int q0 = stid, q1 = stid + 256;
        t0 = *(const u32x4*)(sw + SW_W2 + (size_t)(h * 64 + (q0 >> 3)) * 64 + (q0 & 7) * 8); t1 = *(const u32x4*)(sw + SW_W2 + (size_t)(h * 64 + (q1 >> 3)) * 64 + (q1 & 7) * 8);
        t2 = *(const u32x4*)(sw + SW_A2 + (size_t)(h * 64 + (q0 >> 3)) * 64 + (q0 & 7) * 8); t3 = *(const u32x4*)(sw + SW_A2 + (size_t)(h * 64 + (q1 >> 3)) * 64 + (q1 & 7) * 8);
        *(u32x4*)(smem + (q0 >> 3) * 144 + (q0 & 7) * 16) = t0; *(u32x4*)(smem + (q1 >> 3) * 144 + (q1 & 7) * 16) = t1;
        *(u32x4*)(smem + 9216 + (q0 >> 3) * 144 + (q0 & 7) * 16) = t2; *(u32x4*)(smem + 9216 + (q1 >> 3) * 144 + (q1 & 7) * 16) = t3; }
      __builtin_amdgcn_sched_barrier(0);
      { const int q0 = stid, q1 = stid + 256, q2 = stid + 512, q3 = stid + 768;
        t0 = *(const u32x4*)(sw + SW_G2 + (size_t)(h * 64 + (q0 >> 4)) * 128 + (q0 & 15) * 8); t1 = *(const u32x4*)(sw + SW_G2 + (size_t)(h * 64 + (q1 >> 4)) * 128 + (q1 & 15) * 8);
        t2 = *(const u32x4*)(sw + SW_G2 + (size_t)(h * 64 + (q2 >> 4)) * 128 + (q2 & 15) * 8); t3 = *(const u32x4*)(sw + SW_G2 + (size_t)(h * 64 + (q3 >> 4)) * 128 + (q3 & 15) * 8);
        *(u32x4*)(smem + 18432 + (q0 >> 4) * 272 + (q0 & 15) * 16) = t0; *(u32x4*)(smem + 18432 + (q1 >> 4) * 272 + (q1 & 15) * 16) = t1;
        *(u32x4*)(smem + 18432 + (q2 >> 4) * 272 + (q2 & 15) * 16) = t2; *(u32x4*)(smem + 18432 + (q3 >> 4) * 272 + (q3 & 15) * 16) = t3; }
    }
    __syncthreads();
    const int cb = h * 64 + 8 * fq;
    __builtin_amdgcn_sched_barrier(0);
    float ss = 0.f;
    {
      float k16[16];
      shift8(384 + cb, k16); shift8(384 + cb + 32, k16 + 8);
#pragma unroll
      for (int q = 0; q < 4; ++q) {
        const float4 kkv = *(const float4*)(kkp + cb + 32 * (q >> 1) + 4 * (q & 1));
        const float x0 = k16[4 * q] * kkv.x, x1 = k16[4 * q + 1] * kkv.y, x2 = k16[4 * q + 2] * kkv.z, x3 = k16[4 * q + 3] * kkv.w;
        ss += x0 * x0 + x1 * x1 + x2 * x2 + x3 * x3;
      }
    }
    ss += __shfl_xor(ss, 16); ss += __shfl_xor(ss, 32);
    const float inv = 1.f / fmaxf(sqrtf(ss), 1e-12f);
    float bsum = 0.f;
#pragma unroll 1
    for (int half = 0; half < 2; ++half) {
      f32x4 lw[2], la[2], lg[2], lv[2];
#pragma unroll
      for (int n2 = 0; n2 < 2; ++n2) {
        const int nt = 2 * half + n2;
        lw[n2] = (f32x4){0.f, 0.f, 0.f, 0.f}; la[n2] = lw[n2]; lg[n2] = lw[n2]; lv[n2] = lw[n2];
        const int rloc = 32 * half + 8 * (fr >> 2) + 4 * n2 + (fr & 3);
        const int crow = h * 64 + rloc;
#pragma unroll
        for (int ks = 0; ks < 2; ++ks) {
          lw[n2] = MFMA16(*(const bf16x8*)(smem + rloc * 144 + (ks * 4 + fq) * 16), Bw[ks], lw[n2]);
          la[n2] = MFMA16(*(const bf16x8*)(smem + 9216 + rloc * 144 + (ks * 4 + fq) * 16), Ba[ks], la[n2]);
        }
#pragma unroll
        for (int ks = 0; ks < 4; ++ks) lg[n2] = MFMA16(*(const bf16x8*)(smem + 18432 + rloc * 272 + (ks * 4 + fq) * 16), Bg[ks], lg[n2]);
        if (l == 1) {
          const u32x2 lo = *(const u32x2*)(sw + SW_V2 + (size_t)crow * 32 + 4 * fq);
          const u32x2 hi = *(const u32x2*)(sw + SW_V2 + (size_t)crow * 32 + 16 + 4 * fq);
          u32x4 av = {lo.x, lo.y, hi.x, hi.y};
          lv[n2] = MFMA16(*reinterpret_cast<bf16x8*>(&av), Bu, lv[n2]);
        }
      }
      const int c8 = cb + 32 * half;
      const size_t o = (size_t)tok * 384 + c8;
      float r8[8], v8[8], k8[8], w0a[8], a0a[8], kaa[8], rka[8], kka[8];
      shift8(c8, r8); shift8(768 + c8, v8); shift8(384 + c8, k8);
#pragma unroll
      for (int q = 0; q < 2; ++q) {
        const float4 t0 = *(const float4*)(w0 + c8 + 4 * q), t1 = *(const float4*)(a0p + c8 + 4 * q), t2 = *(const float4*)(kap + c8 + 4 * q), t3 = *(const float4*)(rkp + c8 + 4 * q);
        const float4 t4 = *(const float4*)(kkp + c8 + 4 * q);
        kka[4 * q] = t4.x; kka[4 * q + 1] = t4.y; kka[4 * q + 2] = t4.z; kka[4 * q + 3] = t4.w;
        w0a[4 * q] = t0.x; w0a[4 * q + 1] = t0.y; w0a[4 * q + 2] = t0.z; w0a[4 * q + 3] = t0.w;
        a0a[4 * q] = t1.x; a0a[4 * q + 1] = t1.y; a0a[4 * q + 2] = t1.z; a0a[4 * q + 3] = t1.w;
        kaa[4 * q] = t2.x; kaa[4 * q + 1] = t2.y; kaa[4 * q + 2] = t2.z; kaa[4 * q + 3] = t2.w;
        rka[4 * q] = t3.x; rka[4 * q + 1] = t3.y; rka[4 * q + 2] = t3.z; rka[4 * q + 3] = t3.w;
      }
      if (l == 1) {
        float vf[8], v0a[8]; unpack8(*(const u32x4*)(VF + o), vf);
        const float4 t0 = *(const float4*)(v0p + c8), t1 = *(const float4*)(v0p + c8 + 4);
        v0a[0] = t0.x; v0a[1] = t0.y; v0a[2] = t0.z; v0a[3] = t0.w; v0a[4] = t1.x; v0a[5] = t1.y; v0a[6] = t1.z; v0a[7] = t1.w;
#pragma unroll
        for (int e8 = 0; e8 < 8; ++e8) v8[e8] = v8[e8] + (vf[e8] - v8[e8]) * sigmoidf_(v0a[e8] + lv[e8 >> 2][e8 & 3]);
      } else {
        *(bf16x8*)(VF + o) = pack8(v8);
      }
      float dec[8], kf[8], an[8], bn[8], gg[8];
#pragma unroll
      for (int e8 = 0; e8 < 8; ++e8) {
        const int nt = e8 >> 2, j = e8 & 3, e = 8 * half + e8;
        dec[e8] = 1.f - __expf(-0.60653066f * sigmoidf_(w0a[e8] + lw[nt][j]));
        const float sa = sigmoidf_(a0a[e8] + la[nt][j]);
        const float kn = k8[e8] * kka[e8] * inv;
        an[e8] = -kn; bn[e8] = kn * sa;
        kf[e8] = k8[e8] * (1.f + (sa - 1.f) * kaa[e8]);
        bsum += r8[e8] * kf[e8] * rka[e8];
        gg[e8] = lg[nt][j];
      }
      *(bf16x8*)(SWp + o) = pack8(dec);
      *(bf16x8*)(SR + o) = pack8(r8);
      *(bf16x8*)(SK + o) = pack8(kf);
      *(bf16x8*)(SV + o) = pack8(v8);
      *(bf16x8*)(Gp + o) = pack8(gg);
      *(bf16x8*)(SA + o) = pack8(an);
      *(bf16x8*)(SBp + o) = pack8(bn);
    }
    bsum += __shfl_xor(bsum, 16); bsum += __shfl_xor(bsum, 32);
    if (fq == 0) bonus[(size_t)tok * 6 + h] = bsum;
  }
}

__device__ void pool_task(const Params& p, int l, int tok0) {
  const int lane = otid() & 63, fr = lane & 15, fq = lane >> 4;
  const int tok = tok0 + fr, t = tok & 4095;
  const bf16_t* u = (const bf16_t*)(p.ws + OFF_POOL) + (size_t)tok * 256;
  const bf16_t* pt = (const bf16_t*)(p.ws + OFF_SMALLW) + (size_t)l * SW_LAYER + SW_POOL;
  bf16_t* mix = (bf16_t*)(p.ws + OFF_HBUF);
#pragma unroll
  for (int g = 0; g < 4; ++g) {
    const int w = 2 << g;
    const int cnt = (t + 1) < w ? (t + 1) : w;
    const float icnt = 1.f / (float)cnt;
    bf16x8 B[2];
#pragma unroll
    for (int ks = 0; ks < 2; ++ks) {
      const int c = g * 64 + ks * 32 + fq * 8;
      float s[8], f[8], u0[8];
      unpack8(*(const u32x4*)(u + c), u0);
#pragma unroll
      for (int i = 0; i < 8; ++i) s[i] = u0[i];
#pragma unroll
      for (int d0 = 1; d0 < w; d0 += 8) {
        u32x4 wr_[8];
#pragma unroll
        for (int q = 0; q < 8; ++q) { const int d = d0 + q; if (d < w) { const int dd = d < cnt ? d : 0; wr_[q] = *(const u32x4*)(u + c - (size_t)dd * 256); } }
#pragma unroll
        for (int q = 0; q < 8; ++q) { const int d = d0 + q; if (d < w) { unpack8(wr_[q], f);
#pragma unroll
          for (int i = 0; i < 8; ++i) s[i] += (d < cnt) ? f[i] : 0.f; } }
      }
#pragma unroll
      for (int i = 0; i < 8; ++i) s[i] = s[i] * icnt - u0[i];
      B[ks] = pack8(s);
    }
    float yo[16];
#pragma unroll
    for (int nt = 0; nt < 4; ++nt) {
      f32x4 acc = {0.f, 0.f, 0.f, 0.f};
      const int drow = 32 * (nt >> 1) + 8 * (fr >> 2) + 4 * (nt & 1) + (fr & 3);
#pragma unroll
      for (int ks = 0; ks < 2; ++ks) acc = MFMA16(*(const bf16x8*)(pt + (size_t)g * 4096 + (size_t)drow * 64 + ks * 32 + fq * 8), B[ks], acc);
      const int d = 32 * (nt >> 1) + 8 * fq + 4 * (nt & 1);
      const float4 bv = *(const float4*)(p.pool_b + (size_t)(l * 4 + g) * 64 + d);
      const float4 sv = *(const float4*)(p.pool_scale + (size_t)l * 256 + g * 64 + d);
      yo[4 * nt] = (acc[0] + bv.x) * sv.x; yo[4 * nt + 1] = (acc[1] + bv.y) * sv.y; yo[4 * nt + 2] = (acc[2] + bv.z) * sv.z; yo[4 * nt + 3] = (acc[3] + bv.w) * sv.w;
    }
    *(bf16x8*)(mix + (size_t)tok * 1024 + 768 + g * 64 + 8 * fq) = pack8(yo);
    *(bf16x8*)(mix + (size_t)tok * 1024 + 768 + g * 64 + 32 + 8 * fq) = pack8(yo + 8);
  }
}

__device__ void scan_block(const Params& p, int sb, unsigned char* smem) {
  const int tid = otid(), lane = tid & 63, wave = tid >> 6, rr = lane >> 4, c = lane & 15;
  const int bh = sb >> 2, rq = sb & 3, b = bh / 6, h = bh - b * 6;
  const int rloc = wave * 4 + rr;
  const int row = rq * 16 + rloc;
  const size_t base = (size_t)b * 4096 * 384 + h * 64;
  const bf16_t* SR = (const bf16_t*)(p.ws + OFF_SR); const bf16_t* SK = (const bf16_t*)(p.ws + OFF_SK); const bf16_t* SV = (const bf16_t*)(p.ws + OFF_SV);
  const bf16_t* SA = (const bf16_t*)(p.ws + OFF_SA); const bf16_t* SBp = (const bf16_t*)(p.ws + OFF_SB); const bf16_t* SWp = (const bf16_t*)(p.ws + OFF_SW);
  float* Y = (float*)(p.ws + OFF_PROJR);
  float* lds = (float*)smem;
  constexpr int STEP = 336, BUF = 16 * STEP;
  const int q0 = tid, q1 = tid + 256;
  const int arr0 = q0 >> 7, st0 = (q0 & 127) >> 3, pt0 = q0 & 7;
  const int arr1 = q1 >> 7, st1 = (q1 & 127) >> 3, pt1 = q1 & 7;
  const bf16_t* src0 = (arr0 == 0 ? SA : SBp) + base + (size_t)st0 * 384 + pt0 * 8;
  const bf16_t* src1 = (arr1 == 2 ? SK : SR) + base + (size_t)st1 * 384 + pt1 * 8;
  const int slot0 = (arr0 == 0 ? 0 : 64), slot1 = (arr1 == 2 ? 192 : 256);
  const int stw = (tid & 127) >> 3, ptw = tid & 7;
  const bf16_t* srcw = SWp + base + (size_t)stw * 384 + ptw * 8;
  const int stv = (tid & 63) >> 2, ptv = tid & 3;
  const bf16_t* srcv = SV + base + (size_t)stv * 384 + rq * 16 + ptv * 4;
  u32x4 g0, g1, gw = {0u, 0u, 0u, 0u}; u32x2 gv = {0u, 0u};
  auto gload = [&](int ch) {
    const size_t o = (size_t)ch * 16 * 384;
    g0 = *(const u32x4*)(src0 + o); g1 = *(const u32x4*)(src1 + o); if (tid < 128) gw = *(const u32x4*)(srcw + o);
    if (tid < 64) gv = *(const u32x2*)(srcv + o);
  };
  auto lwrite = [&](int bufi) {
    float* L = lds + bufi * BUF;
    float f[8];
    unpack8(g0, f);
    *(float4*)(L + st0 * STEP + slot0 + pt0 * 8) = make_float4(f[0], f[1], f[2], f[3]); *(float4*)(L + st0 * STEP + slot0 + pt0 * 8 + 4) = make_float4(f[4], f[5], f[6], f[7]);
    unpack8(g1, f);
    *(float4*)(L + st1 * STEP + slot1 + pt1 * 8) = make_float4(f[0], f[1], f[2], f[3]); *(float4*)(L + st1 * STEP + slot1 + pt1 * 8 + 4) = make_float4(f[4], f[5], f[6], f[7]);
    if (tid < 128) { unpack8(gw, f); *(float4*)(L + stw * STEP + 128 + ptw * 8) = make_float4(1.f - f[0], 1.f - f[1], 1.f - f[2], 1.f - f[3]); *(float4*)(L + stw * STEP + 128 + ptw * 8 + 4) = make_float4(1.f - f[4], 1.f - f[5], 1.f - f[6], 1.f - f[7]); }
    if (tid < 64) { float v4[4]; unpack4(gv, v4); *(float4*)(L + stv * STEP + 320 + ptv * 4) = make_float4(v4[0], v4[1], v4[2], v4[3]); }
  };
  f32x2_t s01 = {0.f, 0.f}, s23 = {0.f, 0.f};
  gload(0); lwrite(0);
  __syncthreads();
  f32x4 qA[2][2], qB[2][2], qW[2][2], qK[2][2], qR[2][2]; float qv[2][2];
#define SLOAD(set, Lp, g) do { _Pragma("unroll") for (int _u = 0; _u < 2; ++_u) { const float* _Ls = (Lp) + ((g) * 2 + _u) * STEP; \
    qA[set][_u] = *(const f32x4*)(_Ls + 4 * c); qB[set][_u] = *(const f32x4*)(_Ls + 64 + 4 * c); qW[set][_u] = *(const f32x4*)(_Ls + 128 + 4 * c); \
    qK[set][_u] = *(const f32x4*)(_Ls + 192 + 4 * c); qR[set][_u] = *(const f32x4*)(_Ls + 256 + 4 * c); qv[set][_u] = _Ls[320 + rloc]; } } while (0)
#define SSTEP(set, u, stidx) do { \
    const f32x4 A = qA[set][u], Bv = qB[set][u], W = qW[set][u], Kv = qK[set][u], R = qR[set][u]; const float v = qv[set][u]; \
    const f32x2_t vv = {v, v}; \
    const f32x2_t A01 = {A[0], A[1]}, A23 = {A[2], A[3]}, B01 = {Bv[0], Bv[1]}, B23 = {Bv[2], Bv[3]}, W01 = {W[0], W[1]}, W23 = {W[2], W[3]}; \
    const f32x2_t K01 = {Kv[0], Kv[1]}, K23 = {Kv[2], Kv[3]}, R01 = {R[0], R[1]}, R23 = {R[2], R[3]}; \
    const f32x2_t pd2 = s01 * A01 + s23 * A23; \
    const f32x2_t t01 = s01 * W01 + vv * K01, t23 = s23 * W23 + vv * K23; \
    const float pdot = rowsum16(pd2[0] + pd2[1]); \
    const f32x2_t pp = {pdot, pdot}; \
    s01 = pp * B01 + t01; s23 = pp * B23 + t23; \
    const f32x2_t y2 = s01 * R01 + s23 * R23; \
    yp[stidx] = y2[0] + y2[1]; } while (0)
  for (int ch = 0; ch < 256; ++ch) {
    const float* L = lds + (ch & 1) * BUF;
    if (ch + 1 < 256) gload(ch + 1);
    float yp[16];
    SLOAD(0, L, 0);
#pragma unroll
    for (int g = 0; g < 8; g += 2) {
      SLOAD(1, L, g + 1);
      SSTEP(0, 0, g * 2); SSTEP(0, 1, g * 2 + 1);
      if (g + 2 < 8) SLOAD(0, L, g + 2);
      SSTEP(1, 0, g * 2 + 2); SSTEP(1, 1, g * 2 + 3);
    }
    float ykeep;
    {
      const bool m8 = (c & 8) != 0, m4 = (c & 4) != 0, m2 = (c & 2) != 0, m1 = (c & 1) != 0;
      float r8[8], r4[4], r2[2];
#pragma unroll
      for (int i = 0; i < 8; ++i) { const float keep = m8 ? yp[i + 8] : yp[i], send = m8 ? yp[i] : yp[i + 8]; r8[i] = keep + dppf<0x140>(send); }
#pragma unroll
      for (int i = 0; i < 4; ++i) { const float keep = m4 ? r8[i + 4] : r8[i], send = m4 ? r8[i] : r8[i + 4]; r4[i] = keep + dppf<0x141>(send); }
#pragma unroll
      for (int i = 0; i < 2; ++i) { const float keep = m2 ? r4[i + 2] : r4[i], send = m2 ? r4[i] : r4[i + 2]; r2[i] = keep + dppf<0x4E>(send); }
      { const float keep = m1 ? r2[1] : r2[0], send = m1 ? r2[0] : r2[1]; ykeep = keep + dppf<0xB1>(send); }
    }
    Y[base + (size_t)(ch * 16 + c) * 384 + row] = ykeep;
    if (ch + 1 < 256) lwrite((ch + 1) & 1);
    __syncthreads();
  }
#undef SLOAD
#undef SSTEP
}

__device__ void attn_task(const Params& p, int task) {
  const int lane = otid() & 63, r = lane & 31, hh = lane >> 5;
  const int bh = task >> 7, qt = 127 - (task & 127);
  const int b = bh / 6, h = bh - b * 6;
  const int t0 = qt * 32;
  const bf16_t* sbq = (const bf16_t*)(p.ws + OFF_SBQ); const bf16_t* sbk = (const bf16_t*)(p.ws + OFF_SBK); const bf16_t* sbvt = (const bf16_t*)(p.ws + OFF_SBVT);
  bf16x8 qf[4];
  {
    const bf16_t* qb = sbq + ((size_t)bh * 4096 + t0 + r) * 64 + 8 * hh;
#pragma unroll
    for (int ks = 0; ks < 4; ++ks) qf[ks] = *(const bf16x8*)(qb + 16 * ks);
  }
  f32x16 o0, o1;
#pragma unroll
  for (int i = 0; i < 16; ++i) { o0[i] = 0.f; o1[i] = 0.f; }
  float crun = 0.f;
  for (int kb = qt; kb >= 0; --kb) {
    const bf16_t* kp = sbk + ((size_t)bh * 4096 + kb * 32 + r) * 64 + 8 * hh;
    f32x16 s;
#pragma unroll
    for (int i = 0; i < 16; ++i) s[i] = 0.f;
#pragma unroll
    for (int ks = 0; ks < 4; ++ks) s = MFMA32(*(const bf16x8*)(kp + 16 * ks), qf[ks], s);
    const bool diag = (kb == qt);
    float C[16], tg[4], ptn[4], both[4], suf[4];
    bool cz[16];
#pragma unroll
    for (int g = 0; g < 4; ++g) {
      float run = 0.f;
#pragma unroll
      for (int i = 3; i >= 0; --i) {
        const int reg = 4 * g + i;
        const int key = i + 8 * g + 4 * hh;
        const bool causal = (!diag) || (key < r);
        cz[reg] = causal;
        const float L = causal ? -softplusf_(s[reg]) : 0.f;
        run += L;
        C[reg] = run;
      }
      tg[g] = run;
    }
#pragma unroll
    for (int g = 0; g < 4; ++g) { ptn[g] = __shfl_xor(tg[g], 32); both[g] = tg[g] + ptn[g]; }
    suf[3] = 0.f; suf[2] = both[3]; suf[1] = suf[2] + both[2]; suf[0] = suf[1] + both[1];
    float A[16];
#pragma unroll
    for (int g = 0; g < 4; ++g) {
      const float off = suf[g] + (hh == 0 ? ptn[g] : 0.f) + crun;
#pragma unroll
      for (int i = 0; i < 4; ++i) { const int reg = 4 * g + i; A[reg] = cz[reg] ? __expf(s[reg] + C[reg] + off) : 0.f; }
    }
    crun += suf[0] + both[0];
#pragma unroll
    for (int s2 = 0; s2 < 2; ++s2) {
      const bf16x8 pf = pack8(&A[8 * s2]);
      {
        const bf16_t* vp = sbvt + ((size_t)bh * 64 + r) * 4096 + kb * 32 + 16 * s2 + 4 * hh;
        const u32x2 lo = *(const u32x2*)vp, hi = *(const u32x2*)(vp + 8);
        u32x4 vv = {lo.x, lo.y, hi.x, hi.y};
        o0 = MFMA32(pf, *reinterpret_cast<bf16x8*>(&vv), o0);
      }
      {
        const bf16_t* vp = sbvt + ((size_t)bh * 64 + 32 + r) * 4096 + kb * 32 + 16 * s2 + 4 * hh;
        const u32x2 lo = *(const u32x2*)vp, hi = *(const u32x2*)(vp + 8);
        u32x4 vv = {lo.x, lo.y, hi.x, hi.y};
        o1 = MFMA32(pf, *reinterpret_cast<bf16x8*>(&vv), o1);
      }
    }
    if (__ballot(crun >= -110.f) == 0ull) break;
  }
  bf16_t* mix = (bf16_t*)(p.ws + OFF_HBUF);
#pragma unroll
  for (int reg = 0; reg < 16; ++reg) {
    const int q = (reg & 3) + 8 * (reg >> 2) + 4 * hh;
    bf16_t* d = mix + ((size_t)b * 4096 + t0 + q) * 1024 + 384 + h * 64 + r;
    d[0] = f2bf(o0[reg]); d[32] = f2bf(o1[reg]);
  }
}

__device__ void post_phase(const Params& p, int l, int gt, int nt) {
  const float* Y = (const float*)(p.ws + OFF_PROJR); const bf16_t* SV = (const bf16_t*)(p.ws + OFF_SV); const bf16_t* Gp = (const bf16_t*)(p.ws + OFF_G);
  const float* bonus = (const float*)(p.ws + OFF_BONUS);
  bf16_t* mix = (bf16_t*)(p.ws + OFF_HBUF);
  const int total = M_ * 96;
  for (int i = gt; i < total; i += nt) {
    const int tok = i / 96, cgp = i - tok * 96, c = cgp * 4, h = cgp >> 4;
    const size_t o = (size_t)tok * 384 + c;
    const f32x4 yt_ = __builtin_nontemporal_load((const f32x4*)(Y + o));
    const float4 y = make_float4(yt_[0], yt_[1], yt_[2], yt_[3]);
    float v4[4], g4[4]; unpack4(__builtin_nontemporal_load((const u32x2*)(SV + o)), v4); unpack4(__builtin_nontemporal_load((const u32x2*)(Gp + o)), g4);
    const float mean = rowsum16((y.x + y.y) + (y.z + y.w)) * (1.f / 64.f);
    const float d0 = y.x - mean, d1 = y.y - mean, d2 = y.z - mean, d3 = y.w - mean;
    const float var = rowsum16((d0 * d0 + d1 * d1) + (d2 * d2 + d3 * d3)) * (1.f / 64.f);
    const float rs = rsqrtf(var + 64e-5f);
    const float4 lw = *(const float4*)(p.lnx_w + l * 384 + c), lb = *(const float4*)(p.lnx_b + l * 384 + c);
    const float bo = bonus[(size_t)tok * 6 + h];
    *(u32x2*)(mix + (size_t)tok * 1024 + c) = pack4((d0 * rs * lw.x + lb.x + bo * v4[0]) * g4[0], (d1 * rs * lw.y + lb.y + bo * v4[1]) * g4[1],
                                                    (d2 * rs * lw.z + lb.z + bo * v4[2]) * g4[2], (d3 * rs * lw.w + lb.w + bo * v4[3]) * g4[3]);
  }
}

__global__ void __launch_bounds__(256, 2) fwd_megakernel(Params p) {
  __shared__ __attribute__((aligned(16))) unsigned char smem[65536];
  GridBar gb; gb.bar = (unsigned*)(p.ws + OFF_BAR); gb.nloc = 0u; gb.nx = 0u;
  gb.x = (unsigned)__builtin_amdgcn_s_getreg((3 << 11) | 20) & 0xFu;
  if (threadIdx.x == 0) (void)xb_add(&gb.bar[XB_XCNT(gb.x)], 1u);
  const int bid = blockIdx.x, G = gridDim.x;
#define wave (otid() >> 6)
#define gw (bid * 4 + (otid() >> 6))
#define gt (bid * 256 + otid())
  const int vb = (bid & 7) * (G >> 3) + (bid >> 3);
  const int nw = G * 4, ngt = G * 256;
  bf16_t* hbuf = (bf16_t*)(p.ws + OFF_HBUF);

  prep_phase(p, 0, vb, G, gt, ngt, smem);
  norm_phase(p.x, p.ln1_g, hbuf, gw, nw);
  grid_barrier(gb);
#pragma unroll 1
  for (int l = 0; l < 2; ++l) {
    if (l > 0) { norm_phase(p.out, p.ln1_g + 1024, hbuf, gw, nw); grid_barrier(gb); }
    gemm_phase<0>(p, l, vb, G, smem);
    grid_barrier(gb);
    for (int blk = bid; blk < 512; blk += G) rwkv_prep_task(p, l, (blk * 4 + wave) * 16, smem);
    grid_barrier(gb);
    if (bid < 192) scan_block(p, bid, smem);
    else {
      for (int task = (bid - 192) * 4 + wave; task < 6144; task += (G - 192) * 4) attn_task(p, task);
      for (int task = (bid - 192) * 4 + wave; task < 2048; task += (G - 192) * 4) pool_task(p, l, task * 16);
      if (l == 0) { __syncthreads(); prep_phase(p, 1, bid - 192, G - 192, (bid - 192) * 256 + otid(), (G - 192) * 256, smem); }
    }
    grid_barrier(gb);
    post_phase(p, l, gt, ngt);
    grid_barrier(gb);
    gemm_phase<1>(p, l, vb, G, smem);
    grid_barrier(gb);
    norm_phase(p.out, p.ln2_g + l * 1024, hbuf, gw, nw);
    grid_barrier(gb);
    gemm_phase<2>(p, l, vb, G, smem);
    grid_barrier(gb);
    gemm_phase<3>(p, l, vb, G, smem);
    if (l == 0) grid_barrier(gb);
  }
}

#undef wave
#undef gw
#undef gt

extern "C" void kernel_launch(void* const* d_in, const int* in_sizes, int n_in, void* d_out, int out_size, void* d_ws, size_t ws_size, hipStream_t stream) {
  static int grid_blocks = 0;
  if (!grid_blocks) {
    int dev = 0, cus = 0, per_cu = 0;
    (void)hipGetDevice(&dev);
    (void)hipDeviceGetAttribute(&cus, hipDeviceAttributeMultiprocessorCount, dev);
    (void)hipOccupancyMaxActiveBlocksPerMultiprocessor(&per_cu, fwd_megakernel, 256, 0);
    if (per_cu > 2) per_cu = 2;
    if (per_cu < 1) per_cu = 1;
    if (cus <= 0) cus = 256;
    grid_blocks = cus * per_cu;
    grid_blocks &= ~7;
  }
  Params p{};
  p.x = (const float*)d_in[0]; p.ln1_g = (const float*)d_in[1]; p.w_in = (const float*)d_in[2]; p.mu = (const float*)d_in[3]; p.w0 = (const float*)d_in[4];
  p.w2 = (const float*)d_in[5]; p.a0 = (const float*)d_in[6]; p.a2 = (const float*)d_in[7]; p.g2 = (const float*)d_in[8]; p.k_k = (const float*)d_in[9];
  p.k_a = (const float*)d_in[10]; p.r_k = (const float*)d_in[11]; p.lnx_w = (const float*)d_in[12]; p.lnx_b = (const float*)d_in[13]; p.v0 = (const float*)d_in[14];
  p.v1 = (const float*)d_in[15]; p.v2 = (const float*)d_in[16]; p.q_gain = (const float*)d_in[17]; p.k_gain = (const float*)d_in[18]; p.pool_w = (const float*)d_in[19];
  p.pool_b = (const float*)d_in[20]; p.pool_scale = (const float*)d_in[21]; p.w_out = (const float*)d_in[22]; p.ln2_g = (const float*)d_in[23];
  p.w_up = (const float*)d_in[24]; p.conv_w = (const float*)d_in[25]; p.conv_b = (const float*)d_in[26]; p.w_down = (const float*)d_in[27];
  p.out = (float*)d_out; p.ws = (unsigned char*)d_ws;
  (void)hipMemsetAsync(d_ws, 0, XB_BYTES, stream);
  void* args[] = {&p};
  hipError_t e = hipLaunchCooperativeKernel((const void*)fwd_megakernel, dim3(grid_blocks), dim3(256), args, 0, stream);
  if (e != hipSuccess) fprintf(stderr, "cooperative launch failed: %s (grid %d)\n", hipGetErrorString(e), grid_blocks);
}
```
